# Optimizing an MI355X kernel written in HIP

```python
import math
import jax, jax.numpy as jnp
from jax import lax
import numpy as np

D_MODEL = 1024
BATCH = 2
SEQ = 8192
DEPTH = 1

GRID_W = 64
PLE_DIM = 256
D_FF = 2816
HEAD_DIM = 64
N_Q_HEADS = 8
N_KV_HEADS = 2
GQA_GROUP = N_Q_HEADS // N_KV_HEADS
ATTN_WIDTH = N_Q_HEADS * HEAD_DIM
KV_WIDTH = N_KV_HEADS * HEAD_DIM
Q_BLOCK = 128
ROPE_THETA = 10000.0
ROPE_AXIS_DIM = HEAD_DIM // 2
SSM_WIDTH = D_MODEL // 2
SSM_GROUP = 16
SSM_N_GROUPS = SSM_WIDTH // SSM_GROUP
SSM_STATE = 64
N_DIRS = 2
IN_PROJ_WIDTH = ATTN_WIDTH + 2 * KV_WIDTH + SSM_WIDTH + 2 * D_MODEL
IN_SPLITS = [ATTN_WIDTH,
             ATTN_WIDTH + KV_WIDTH,
             ATTN_WIDTH + 2 * KV_WIDTH,
             ATTN_WIDTH + 2 * KV_WIDTH + SSM_WIDTH,
             ATTN_WIDTH + 2 * KV_WIDTH + SSM_WIDTH + D_MODEL]
NORM_EPS = 1e-6

kernel_name = "hybrid_gqa_s5_macaron_encoder_layer"


def rms_norm(x, g):
    xf = x.astype(jnp.float32)
    y = xf * lax.rsqrt(jnp.mean(xf * xf, axis=-1, keepdims=True) + NORM_EPS)
    return (y * g.astype(jnp.float32)).astype(x.dtype)


def swiglu(x, w_gate, w_up, w_down):
    return (jax.nn.silu(x @ w_gate) * (x @ w_up)) @ w_down


def axial_rope_tables(seq_len):
    rows = seq_len // GRID_W
    row = jnp.repeat(jnp.arange(rows, dtype=jnp.int32), GRID_W).astype(jnp.float32)
    col = jnp.tile(jnp.arange(GRID_W, dtype=jnp.int32), rows).astype(jnp.float32)
    freqs = ROPE_THETA ** (-jnp.arange(0, ROPE_AXIS_DIM, 2, dtype=jnp.float32) / ROPE_AXIS_DIM)
    ang = jnp.concatenate([row[:, None] * freqs, col[:, None] * freqs], axis=-1)
    ang = jnp.concatenate([ang, ang], axis=-1)
    return jnp.cos(ang), jnp.sin(ang)


def apply_rope(x, cos, sin):
    x1, x2 = jnp.split(x, 2, axis=-1)
    rot = jnp.concatenate([-x2, x1], axis=-1)
    return x * cos[None, :, None, :] + rot * sin[None, :, None, :]


def block_gqa_attention(q, k, v):
    b, s = q.shape[0], q.shape[1]
    nb = s // Q_BLOCK
    qb = q.reshape(b, nb, Q_BLOCK, N_KV_HEADS, GQA_GROUP, HEAD_DIM).transpose(1, 0, 2, 3, 4, 5)
    scale = HEAD_DIM ** -0.5

    def one_block(q_blk):
        scores = jnp.einsum('bqkgd,bskd->bkgqs', q_blk, k) * scale
        probs = jax.nn.softmax(scores, axis=-1)
        return jnp.einsum('bkgqs,bskd->bqkgd', probs, v)

    out = lax.map(one_block, qb)
    return out.transpose(1, 0, 2, 3, 4, 5).reshape(b, s, ATTN_WIDTH)


def s5_scan(u_g, lam_re, lam_im, log_step, b_re, b_im, c_re, c_im, reverse):
    f32 = jnp.float32
    lam = lax.complex(lam_re.astype(f32), lam_im.astype(f32))
    delta = jnp.exp(log_step.astype(f32))[:, None]
    lam_bar = jnp.exp(lam * delta)
    b_mat = lax.complex(b_re.astype(f32), b_im.astype(f32))
    b_bar = ((lam_bar - 1.0) / lam)[..., None] * b_mat
    bu = jnp.einsum('gph,bsgh->bsgp', b_bar, u_g.astype(jnp.complex64))
    a = jnp.broadcast_to(lam_bar, bu.shape)

    def combine(e1, e2):
        a1, x1 = e1
        a2, x2 = e2
        return a1 * a2, a2 * x1 + x2

    _, states = lax.associative_scan(combine, (a, bu), reverse=reverse, axis=1)
    c_mat = lax.complex(c_re.astype(f32), c_im.astype(f32))
    return jnp.einsum('ghp,bsgp->bsgh', c_mat, states).real


def setup_inputs(seed: int = 0) -> dict:
    key = jax.random.key(seed)
    ks = iter(jax.random.split(key, 40))
    f32 = jnp.float32

    def w(shape, fan_in):
        return jax.random.normal(next(ks), shape, f32) * (fan_in ** -0.5)

    def gain(shape):
        return 1.0 + 0.02 * jax.random.normal(next(ks), shape, f32)

    L = DEPTH
    G, P, H = SSM_N_GROUPS, SSM_STATE, SSM_GROUP
    n_idx = jnp.arange(P, dtype=f32)
    lam_re = -0.5 + 0.01 * jax.random.normal(next(ks), (L, N_DIRS, G, P), f32)
    lam_im = math.pi * n_idx + 0.01 * jax.random.normal(next(ks), (L, N_DIRS, G, P), f32)
    log_step = jax.random.uniform(next(ks), (L, N_DIRS, G), f32,
                                  minval=math.log(0.001), maxval=math.log(0.1))
    inv_sqrt2 = 0.5 ** 0.5
    return {
        "x": jax.random.normal(next(ks), (BATCH, SEQ, D_MODEL), f32),
        "p": jax.random.normal(next(ks), (DEPTH, BATCH, SEQ, PLE_DIM), f32),
        "ffn1_norm": gain((L, D_MODEL)),
        "ffn1_w_gate": w((L, D_MODEL, D_FF), D_MODEL),
        "ffn1_w_up": w((L, D_MODEL, D_FF), D_MODEL),
        "ffn1_w_down": w((L, D_FF, D_MODEL), D_FF),
        "mix_norm": gain((L, D_MODEL)),
        "w_in": w((L, D_MODEL, IN_PROJ_WIDTH), D_MODEL),
        "q_norm": gain((L, HEAD_DIM)),
        "k_norm": gain((L, HEAD_DIM)),
        "ssm_lambda_re": lam_re,
        "ssm_lambda_im": lam_im,
        "ssm_log_step": log_step,
        "ssm_b_re": w((L, N_DIRS, G, P, H), H) * inv_sqrt2,
        "ssm_b_im": w((L, N_DIRS, G, P, H), H) * inv_sqrt2,
        "ssm_c_re": w((L, N_DIRS, G, H, P), P) * inv_sqrt2,
        "ssm_c_im": w((L, N_DIRS, G, H, P), P) * inv_sqrt2,
        "ssm_d": 0.5 * jax.random.normal(next(ks), (L, SSM_WIDTH), f32),
        "ssm_glu_w": w((L, SSM_WIDTH, SSM_WIDTH), SSM_WIDTH),
        "ssm_glu_b": 0.01 * jax.random.normal(next(ks), (L, SSM_WIDTH), f32),
        "w_attn_branch": w((L, ATTN_WIDTH, D_MODEL), ATTN_WIDTH),
        "w_ssm_branch": w((L, SSM_WIDTH, D_MODEL), SSM_WIDTH),
        "w_out": w((L, D_MODEL, D_MODEL), D_MODEL),
        "ffn2_norm": gain((L, D_MODEL)),
        "ffn2_w_gate": w((L, D_MODEL, D_FF), D_MODEL),
        "ffn2_w_up": w((L, D_MODEL, D_FF), D_MODEL),
        "ffn2_w_down": w((L, D_FF, D_MODEL), D_FF),
        "ple_norm": gain((L, D_MODEL)),
        "ple_w_gate": w((L, D_MODEL, D_MODEL), D_MODEL),
        "ple_w_proj": w((L, PLE_DIM, D_MODEL), PLE_DIM),
    }


def reference(x, p, ffn1_norm, ffn1_w_gate, ffn1_w_up, ffn1_w_down, mix_norm, w_in,
              q_norm, k_norm, ssm_lambda_re, ssm_lambda_im, ssm_log_step, ssm_b_re,
              ssm_b_im, ssm_c_re, ssm_c_im, ssm_d, ssm_glu_w, ssm_glu_b, w_attn_branch,
              w_ssm_branch, w_out, ffn2_norm, ffn2_w_gate, ffn2_w_up, ffn2_w_down,
              ple_norm, ple_w_gate, ple_w_proj):
    f32 = jnp.float32
    b, s, _ = x.shape
    cos, sin = axial_rope_tables(s)
    h = x
    for i in range(DEPTH):
        h = h + 0.5 * swiglu(rms_norm(h, ffn1_norm[i]), ffn1_w_gate[i], ffn1_w_up[i], ffn1_w_down[i])

        u = rms_norm(h, mix_norm[i])
        proj = u @ w_in[i]
        q, k, v, x_ssm, g_attn, g_ssm = jnp.split(proj, IN_SPLITS, axis=-1)

        q = apply_rope(rms_norm(q.reshape(b, s, N_Q_HEADS, HEAD_DIM).astype(f32), q_norm[i]), cos, sin)
        k = apply_rope(rms_norm(k.reshape(b, s, N_KV_HEADS, HEAD_DIM).astype(f32), k_norm[i]), cos, sin)
        v = v.reshape(b, s, N_KV_HEADS, HEAD_DIM).astype(f32)
        y_attn = block_gqa_attention(q, k, v).astype(x.dtype) @ w_attn_branch[i]

        u_g = x_ssm.reshape(b, s, SSM_N_GROUPS, SSM_GROUP)
        y_fwd = s5_scan(u_g, ssm_lambda_re[i, 0], ssm_lambda_im[i, 0], ssm_log_step[i, 0],
                        ssm_b_re[i, 0], ssm_b_im[i, 0], ssm_c_re[i, 0], ssm_c_im[i, 0], reverse=False)
        y_bwd = s5_scan(u_g, ssm_lambda_re[i, 1], ssm_lambda_im[i, 1], ssm_log_step[i, 1],
                        ssm_b_re[i, 1], ssm_b_im[i, 1], ssm_c_re[i, 1], ssm_c_im[i, 1], reverse=True)
        y_s5 = (y_fwd + y_bwd).reshape(b, s, SSM_WIDTH) + ssm_d[i].astype(f32) * x_ssm.astype(f32)
        z = jax.nn.gelu(y_s5).astype(x.dtype)
        z = z * jax.nn.sigmoid(z @ ssm_glu_w[i] + ssm_glu_b[i])
        y_ssm = z @ w_ssm_branch[i]

        merged = jax.nn.sigmoid(g_attn) * y_attn + jax.nn.sigmoid(g_ssm) * y_ssm
        h = h + merged @ w_out[i]

        h = h + 0.5 * swiglu(rms_norm(h, ffn2_norm[i]), ffn2_w_gate[i], ffn2_w_up[i], ffn2_w_down[i])

        ple = p[i] @ ple_w_proj[i]
        h = h + jax.nn.sigmoid(rms_norm(h, ple_norm[i]) @ ple_w_gate[i]) * ple
    return h
```

```cpp
#include <hip/hip_runtime.h>
#include <hip/hip_cooperative_groups.h>
#include <hip/hip_bf16.h>
#include <cstdio>
#include <cstdint>
#include <cmath>
namespace cg = cooperative_groups;

#define LAS __attribute__((address_space(3)))
#define GAS __attribute__((address_space(1)))

constexpr int M = 16384, DM = 1024, FF = 2816, NIN = 3328, SEQ = 8192, PLE = 256;
constexpr float NORM_EPS = 1e-6f;
constexpr float C2 = 0.125f * 1.4426950408889634f;

namespace pg8 {
typedef unsigned short bf16_t;
typedef short bf16x8 __attribute__((ext_vector_type(8)));
typedef float f32x4 __attribute__((ext_vector_type(4)));
typedef unsigned u32x4 __attribute__((ext_vector_type(4)));
typedef unsigned u32x2 __attribute__((ext_vector_type(2)));
constexpr int BM = 256, BK = 64, HALF = 128, HTB = HALF * BK * 2, STAGE_BYTES = 8 * HTB, NXCD = 8, WGM = 8;

__host__ __device__ __forceinline__ int lds_byte(int r, int c) { const int st = (r >> 4) * 2 + (c >> 5), rr = r & 15, cc = c & 31, ob = rr * 64 + cc * 2; return st * 1024 + (ob ^ (((ob >> 9) & 1) << 5)); }
__host__ __device__ __forceinline__ void stage_rc(int b, int& R, int& C) { const int st = b / 1024, sb = b % 1024, swz = sb ^ (((sb >> 9) & 1) << 5); R = (st >> 1) * 16 + swz / 64; C = (st & 1) * 32 + (swz % 64) / 2; }
__host__ __device__ __forceinline__ int perm32(int rho) { const int n = rho >> 4, i = rho & 15; return 8 * (i >> 2) + 4 * n + (i & 3); }

struct Unit { int pm, pn, pb; };
struct Gemm { const bf16_t* A; const bf16_t* Bt; int M, N, K, lda, ldb; size_t sA, sB; int nb; size_t ksA = 0, tsA_ = 0; };

struct StaticOrder {
    int nM, nN, per, nwg, G, c;
    __device__ void init(int M_, int N_, int nb, int G_, int c_) { nM = M_ / BM; nN = N_ / BM; per = nM * nN; nwg = per * nb; G = G_; c = c_; }
    __device__ bool next(int i, Unit& u) const {
        const long L = (long)i * G + c; if (L >= nwg) return false;
        int wgid = (int)L; { const int q = nwg / NXCD, r = nwg % NXCD, xcd = wgid % NXCD, off = wgid / NXCD; wgid = (xcd < r ? xcd * (q + 1) : r * (q + 1) + (xcd - r) * q) + off; }
        u.pb = wgid / per; wgid -= u.pb * per;
        const int nig = WGM * nN, gid = wgid / nig, fm = gid * WGM, gsz = (nM - fm) < WGM ? (nM - fm) : WGM;
        u.pm = fm + ((wgid % nig) % gsz); u.pn = (wgid % nig) / gsz; return true;
    }
};

__device__ __forceinline__ unsigned cvt_pk_bf16(float lo, float hi) { unsigned r; asm volatile("v_cvt_pk_bf16_f32 %0, %1, %2" : "=v"(r) : "v"(lo), "v"(hi)); return r; }
__device__ __forceinline__ float bf_lo(unsigned w) { return __uint_as_float(w << 16); }
__device__ __forceinline__ float bf_hi(unsigned w) { return __uint_as_float(w & 0xffff0000u); }
__device__ __forceinline__ float sigm(float x) { return __builtin_amdgcn_rcpf(1.0f + __builtin_amdgcn_exp2f(-1.4426950408889634f * x)); }
__device__ __forceinline__ unsigned q8(const f32x4& v) { return (unsigned)(v[0] * 255.0f + 0.5f) | ((unsigned)(v[1] * 255.0f + 0.5f) << 8) | ((unsigned)(v[2] * 255.0f + 0.5f) << 16) | ((unsigned)(v[3] * 255.0f + 0.5f) << 24); }
__device__ __forceinline__ f32x4 dq8(unsigned w) { return (f32x4){(float)(w & 255u), (float)((w >> 8) & 255u), (float)((w >> 16) & 255u), (float)(w >> 24)} * (1.0f / 255.0f); }
__device__ __forceinline__ f32x4 sigm4(const f32x4& x, float k) { f32x4 d = x * (-1.4426950408889634f * k);
#pragma unroll
    for (int e = 0; e < 4; ++e) d[e] = __builtin_amdgcn_exp2f(d[e]);
    d = d + 1.0f;
#pragma unroll
    for (int e = 0; e < 4; ++e) d[e] = __builtin_amdgcn_rcpf(d[e]);
    return d; }
__device__ __forceinline__ unsigned q8s(const f32x4& s) { const f32x4 v = s * 255.0f + 0.5f; return (unsigned)v[0] | ((unsigned)v[1] << 8) | ((unsigned)v[2] << 16) | ((unsigned)v[3] << 24); }
__device__ __forceinline__ float gelu_tanh(float x) { return x * sigm(1.5957691216057308f * (x + 0.044715f * x * x * x)); }
__device__ __forceinline__ u32x4 pack8(const f32x4& a, const f32x4& b) { u32x4 w; w.x = cvt_pk_bf16(a[0], a[1]); w.y = cvt_pk_bf16(a[2], a[3]); w.z = cvt_pk_bf16(b[0], b[1]); w.w = cvt_pk_bf16(b[2], b[3]); return w; }
__device__ __forceinline__ void unpack8(const u32x4& w, f32x4& a, f32x4& b) { a = (f32x4){bf_lo(w.x), bf_hi(w.x), bf_lo(w.y), bf_hi(w.y)}; b = (f32x4){bf_lo(w.z), bf_hi(w.z), bf_lo(w.w), bf_hi(w.w)}; }
__device__ __forceinline__ float rs_of(const float* ss, int row) { return __builtin_amdgcn_rsqf(ss[row] * (1.0f / 1024.0f) + NORM_EPS); }

#define EPI_ROWS  _Pragma("unroll") for (int ai = 0; ai < 2; ++ai) _Pragma("unroll") for (int m = 0; m < 4; ++m)
typedef const f32x4 (&AccRef)[2][2][4][2];

struct EpiSwiglu {
    static constexpr bool PERM = true;
    const float* ss; bf16_t* act;
    __device__ __forceinline__ void operator()(AccRef acc, const Unit& u, int wr, int wc, int fr, int fq) const {
        const int row0 = u.pm * BM + wr * 64 + fr, col0 = u.pn * 128 + wc * 32 + 8 * fq;
        float rr[2][4];
        EPI_ROWS rr[ai][m] = ss[row0 + ai * HALF + m * 16];
        EPI_ROWS { const int row = row0 + ai * HALF + m * 16; const float r = __builtin_amdgcn_rsqf(rr[ai][m] * (1.0f / 1024.0f) + NORM_EPS);
            f32x4 o[2], d[2]; const float c = -1.4426950408889634f * r, r2 = r * r;
#pragma unroll
            for (int n = 0; n < 2; ++n) { d[n] = acc[ai][0][m][n] * c; o[n] = (acc[ai][0][m][n] * acc[ai][1][m][n]) * r2; }
#pragma unroll
            for (int n = 0; n < 2; ++n)
#pragma unroll
                for (int e = 0; e < 4; ++e) d[n][e] = __builtin_amdgcn_exp2f(d[n][e]);
            d[0] = d[0] + 1.0f; d[1] = d[1] + 1.0f;
#pragma unroll
            for (int n = 0; n < 2; ++n)
#pragma unroll
                for (int e = 0; e < 4; ++e) d[n][e] = __builtin_amdgcn_rcpf(d[n][e]);
            o[0] = o[0] * d[0]; o[1] = o[1] * d[1];
            *(u32x4*)(act + (((size_t)(row >> 8) * (FF / 64) + (col0 >> 6)) * 256 + (row & 255)) * 64 + (col0 & 63)) = pack8(o[0], o[1]); }
    }
};
template <bool BF> struct EpiResid {
    static constexpr bool PERM = true;
    const float* base; bf16_t* xb; float* ssn; float scale;
    __device__ __forceinline__ void operator()(AccRef acc, const Unit& u, int wr, int wc, int fr, int fq) const {
        const int row0 = u.pm * BM + wr * 64 + fr, col0 = u.pn * BM + wc * 32 + 8 * fq;
#pragma unroll
        for (int ai = 0; ai < 2; ++ai) { f32x4 bv[4][2][2]; u32x4 bw[4][2];
#pragma unroll
            for (int m = 0; m < 4; ++m)
#pragma unroll
                for (int bj = 0; bj < 2; ++bj) { const size_t off = (size_t)(row0 + ai * HALF + m * 16) * DM + col0 + bj * HALF;
                    if (BF) bw[m][bj] = *(const u32x4*)(xb + off); else { bv[m][bj][0] = *(const f32x4*)(base + off); bv[m][bj][1] = *(const f32x4*)(base + off + 4); } }
            asm volatile("" ::: "memory");
#pragma unroll
            for (int m = 0; m < 4; ++m) { const int row = row0 + ai * HALF + m * 16; float s = 0.f;
#pragma unroll
                for (int bj = 0; bj < 2; ++bj) { const size_t off = (size_t)row * DM + col0 + bj * HALF;
                    f32x4 b0, b1; if (BF) unpack8(bw[m][bj], b0, b1); else { b0 = bv[m][bj][0]; b1 = bv[m][bj][1]; }
                    const f32x4 h0 = b0 + acc[ai][bj][m][0] * scale, h1 = b1 + acc[ai][bj][m][1] * scale;
                    *(u32x4*)(xb + off) = pack8(h0, h1);
                    s += (h0[0] * h0[0] + h0[1] * h0[1]) + (h0[2] * h0[2] + h0[3] * h0[3]) + (h1[0] * h1[0] + h1[1] * h1[1]) + (h1[2] * h1[2] + h1[3] * h1[3]); }
                s += __shfl_xor(s, 16); s += __shfl_xor(s, 32);
                if (fq == 0) atomicAdd(ssn + row, s); }
            asm volatile("" ::: "memory"); }
    }
};
struct EpiInProj {
    static constexpr bool PERM = true;
    const float* ss; bf16_t* q; bf16_t* k; bf16_t* v; bf16_t* aug; unsigned char* gates; const float* qg; const float* kg;
    __device__ __forceinline__ void operator()(AccRef acc, const Unit& u, int wr, int wc, int fr, int fq) const {
        const int row0 = u.pm * BM + wr * 64 + fr, cw = wc * 32 + 8 * fq, pn = u.pn;
        float rr[2][4];
        EPI_ROWS rr[ai][m] = ss[row0 + ai * HALF + m * 16];
        if (pn < 2 || (pn == 2 && wc < 2)) {
            const float* gn = pn < 2 ? qg : kg; const float sc = pn < 2 ? C2 : 1.0f;
            float g1[8], g2[8], fr8[8];
#pragma unroll
            for (int j = 0; j < 8; ++j) { g1[j] = gn[8 * fq + j] * sc; g2[j] = gn[32 + 8 * fq + j] * sc;
                fr8[j] = __builtin_amdgcn_exp2f(-(float)(8 * (fq & 1) + j) * (13.287712379549449f / 16.0f)) * 0.15915494309189535f; }
            bf16_t* base = pn < 2 ? q + (pn * 4 + wc) * 64 : k + wc * 64; const int pitch = pn < 2 ? 512 : 128;
            EPI_ROWS { const int row = row0 + ai * HALF + m * 16; const float r = __builtin_amdgcn_rsqf(rr[ai][m] * (1.0f / 1024.0f) + NORM_EPS); const int t = row & (SEQ - 1); const float pos = (float)(fq < 2 ? (t >> 6) : (t & 63));
                float x1[8], x2[8]; float s2 = 0.f;
#pragma unroll
                for (int j = 0; j < 8; ++j) { x1[j] = acc[ai][0][m][j >> 2][j & 3] * r; x2[j] = acc[ai][1][m][j >> 2][j & 3] * r; s2 += x1[j] * x1[j] + x2[j] * x2[j]; }
                s2 += __shfl_xor(s2, 16); s2 += __shfl_xor(s2, 32);
                const float rn = __builtin_amdgcn_rsqf(s2 * (1.0f / 64.0f) + NORM_EPS);
                f32x4 o1[2], o2[2];
#pragma unroll
                for (int j = 0; j < 8; ++j) { const float rev = pos * fr8[j], f = rev - __builtin_floorf(rev), sn = __builtin_amdgcn_sinf(f), cs = __builtin_amdgcn_cosf(f);
                    const float y1 = x1[j] * rn * g1[j], y2 = x2[j] * rn * g2[j]; o1[j >> 2][j & 3] = y1 * cs - y2 * sn; o2[j >> 2][j & 3] = y2 * cs + y1 * sn; }
                bf16_t* d = base + (size_t)row * pitch + 8 * fq;
                *(u32x4*)d = pack8(o1[0], o1[1]); *(u32x4*)(d + 32) = pack8(o2[0], o2[1]); }
            return; }
        EPI_ROWS { const int row = row0 + ai * HALF + m * 16; const float r = __builtin_amdgcn_rsqf(rr[ai][m] * (1.0f / 1024.0f) + NORM_EPS);
#pragma unroll
            for (int bj = 0; bj < 2; ++bj) { f32x4 v0 = acc[ai][bj][m][0] * r, v1 = acc[ai][bj][m][1] * r; bf16_t* dst;
                if (pn >= 5) { const f32x4 s0 = sigm4(acc[ai][bj][m][0], r), s1 = sigm4(acc[ai][bj][m][1], r);
                    *(u32x2*)(gates + (size_t)row * 2048 + (pn - 5) * 256 + bj * HALF + cw) = (u32x2){q8s(s0), q8s(s1)}; continue; }
                if (pn == 2) dst = v + (size_t)row * 128 + 64 * (wc - 2) + 32 * bj + 8 * fq;
                else { const int cs = (pn - 3) * 256 + bj * HALF + cw, g = cs >> 4, h0 = cs & 15, b = row >> 13, t = row & 8191, c = t >> 4, tl = t & 15;
                    dst = aug + ((size_t)(g * 1024 + b * 512 + c)) * 512 + tl * 16 + h0; }
                *(u32x4*)dst = pack8(v0, v1); } }
    }
};
struct EpiE {
    static constexpr bool PERM = true;
    float* E;
    __device__ __forceinline__ void operator()(AccRef acc, const Unit& u, int wr, int wc, int fr, int fq) const {
        const int row0 = u.pm * BM + wr * 64 + fr, cw = wc * 32 + 8 * fq;
        EPI_ROWS { const int row = row0 + ai * HALF + m * 16;
#pragma unroll
            for (int bj = 0; bj < 2; ++bj) { float* d = E + ((size_t)(u.pb * 1024 + row)) * 256 + bj * HALF + cw; *(f32x4*)d = acc[ai][bj][m][0]; *(f32x4*)(d + 4) = acc[ai][bj][m][1]; } }
    }
};
struct EpiY {
    static constexpr bool PERM = true;
    bf16_t* z;
    __device__ __forceinline__ void operator()(AccRef acc, const Unit& u, int wr, int wc, int fr, int fq) const {
        const int row0 = u.pm * BM + wr * 64 + fr, cw = wc * 32 + 8 * fq;
        EPI_ROWS { const int row = row0 + ai * HALF + m * 16, b = row >> 9, c = row & 511;
#pragma unroll
            for (int bj = 0; bj < 2; ++bj) { const int nn = bj * HALF + cw, tl = nn >> 4, h0 = nn & 15; f32x4 v0 = acc[ai][bj][m][0], v1 = acc[ai][bj][m][1];
#pragma unroll
                for (int e = 0; e < 1; ++e) { v0 = v0 * sigm4(v0 * (v0 * v0 * 0.044715f + 1.0f), 1.5957691216057308f); v1 = v1 * sigm4(v1 * (v1 * v1 * 0.044715f + 1.0f), 1.5957691216057308f); }
                *(u32x4*)(z + ((size_t)(b * SEQ + c * 16 + tl)) * 512 + u.pb * 16 + h0) = pack8(v0, v1); } }
    }
};
struct EpiGlu {
    static constexpr bool PERM = true;
    const bf16_t* z; const float* bias; bf16_t* z2;
    __device__ __forceinline__ void operator()(AccRef acc, const Unit& u, int wr, int wc, int fr, int fq) const {
        const int row0 = u.pm * BM + wr * 64 + fr, col0 = u.pn * BM + wc * 32 + 8 * fq;
        u32x4 zv[2][4][2]; f32x4 bb[2][2];
        EPI_ROWS
#pragma unroll
            for (int bj = 0; bj < 2; ++bj) zv[ai][m][bj] = *(const u32x4*)(z + (size_t)(row0 + ai * HALF + m * 16) * 512 + col0 + bj * HALF);
#pragma unroll
        for (int bj = 0; bj < 2; ++bj) { bb[bj][0] = *(const f32x4*)(bias + col0 + bj * HALF); bb[bj][1] = *(const f32x4*)(bias + col0 + bj * HALF + 4); }
        asm volatile("" ::: "memory");
        EPI_ROWS { const int row = row0 + ai * HALF + m * 16;
#pragma unroll
            for (int bj = 0; bj < 2; ++bj) { const size_t off = (size_t)row * 512 + col0 + bj * HALF; f32x4 z0, z1; unpack8(zv[ai][m][bj], z0, z1);
                const f32x4 v0 = z0 * sigm4(acc[ai][bj][m][0] + bb[bj][0], 1.0f), v1 = z1 * sigm4(acc[ai][bj][m][1] + bb[bj][1], 1.0f);
                *(u32x4*)(z2 + off) = pack8(v0, v1); } }
    }
};
template <bool ADD> struct EpiBranch {
    static constexpr bool PERM = true;
    const unsigned char* gates; int goff; bf16_t* mg;
    __device__ __forceinline__ void operator()(AccRef acc, const Unit& u, int wr, int wc, int fr, int fq) const {
        const int row0 = u.pm * BM + wr * 64 + fr, col0 = u.pn * BM + wc * 32 + 8 * fq;
#pragma unroll
        for (int ai = 0; ai < 2; ++ai) { u32x2 gv[4][2]; u32x4 pv[4][2];
#pragma unroll
            for (int m = 0; m < 4; ++m)
#pragma unroll
                for (int bj = 0; bj < 2; ++bj) { const int row = row0 + ai * HALF + m * 16, col = col0 + bj * HALF; gv[m][bj] = *(const u32x2*)(gates + (size_t)row * 2048 + goff + col);
                    if (ADD) pv[m][bj] = *(const u32x4*)(mg + (size_t)row * DM + col); }
            asm volatile("" ::: "memory");
#pragma unroll
            for (int m = 0; m < 4; ++m) { const int row = row0 + ai * HALF + m * 16;
#pragma unroll
                for (int bj = 0; bj < 2; ++bj) { const int col = col0 + bj * HALF; const f32x4 g0 = dq8(gv[m][bj].x), g1 = dq8(gv[m][bj].y);
                    f32x4 v0 = acc[ai][bj][m][0] * g0, v1 = acc[ai][bj][m][1] * g1;
                    if (ADD) { f32x4 p0, p1; unpack8(pv[m][bj], p0, p1); v0 += p0; v1 += p1; }
                    *(u32x4*)(mg + (size_t)row * DM + col) = pack8(v0, v1); } }
            asm volatile("" ::: "memory"); }
    }
};
struct EpiPle1 {
    static constexpr bool PERM = true;
    bf16_t* tmp;
    __device__ __forceinline__ void operator()(AccRef acc, const Unit& u, int wr, int wc, int fr, int fq) const {
        const int row0 = u.pm * BM + wr * 64 + fr, col0 = u.pn * BM + wc * 32 + 8 * fq;
        EPI_ROWS { const int row = row0 + ai * HALF + m * 16;
#pragma unroll
            for (int bj = 0; bj < 2; ++bj) *(u32x4*)(tmp + (size_t)row * DM + col0 + bj * HALF) = pack8(acc[ai][bj][m][0], acc[ai][bj][m][1]); }
    }
};
struct EpiPle2 {
    static constexpr bool PERM = true;
    const float* ss; const bf16_t* tmp; const bf16_t* hb; float* out;
    __device__ __forceinline__ void operator()(AccRef acc, const Unit& u, int wr, int wc, int fr, int fq) const {
        const int row0 = u.pm * BM + wr * 64 + fr, col0 = u.pn * BM + wc * 32 + 8 * fq;
        float rr[2][4];
        EPI_ROWS rr[ai][m] = ss[row0 + ai * HALF + m * 16];
#pragma unroll
        for (int ai = 0; ai < 2; ++ai) { u32x4 tv[4][2], hv[4][2];
#pragma unroll
            for (int m = 0; m < 4; ++m)
#pragma unroll
                for (int bj = 0; bj < 2; ++bj) { const size_t off = (size_t)(row0 + ai * HALF + m * 16) * DM + col0 + bj * HALF; tv[m][bj] = *(const u32x4*)(tmp + off); hv[m][bj] = *(const u32x4*)(hb + off); }
            asm volatile("" ::: "memory");
#pragma unroll
            for (int m = 0; m < 4; ++m) { const float r = __builtin_amdgcn_rsqf(rr[ai][m] * (1.0f / 1024.0f) + NORM_EPS);
#pragma unroll
                for (int bj = 0; bj < 2; ++bj) { const size_t off = (size_t)(row0 + ai * HALF + m * 16) * DM + col0 + bj * HALF; f32x4 t0, t1, h0, h1; unpack8(tv[m][bj], t0, t1); unpack8(hv[m][bj], h0, h1);
                    const f32x4 o0 = h0 + sigm4(acc[ai][bj][m][0], r) * t0, o1 = h1 + sigm4(acc[ai][bj][m][1], r) * t1;
                    *(f32x4*)(out + off) = o0; *(f32x4*)(out + off + 4) = o1; } } }
    }
};

template <class Epi, bool ALIGN_EPI>
__device__ __forceinline__ void gemm_phase(LAS unsigned char* lds, const Gemm g, const StaticOrder& S, const Epi& E) {
    int tid_o = threadIdx.x; asm volatile("" : "+v"(tid_o));
    const int tid = tid_o, wid = __builtin_amdgcn_readfirstlane(tid >> 6), lane = tid & 63, wr = wid >> 2, wc = wid & 3, fr = lane & 15, fq = lane >> 4;
    const int K = g.K, nt = K / BK;
    unsigned voffA[2], voffB[2];
#pragma unroll
    for (int i = 0; i < 2; ++i) { int R, C; stage_rc(tid * 16 + i * 8192, R, C); const int Rb = Epi::PERM ? ((R & ~31) + perm32(R & 31)) : R;
        voffA[i] = (unsigned)(R * g.lda + C) * 2u; voffB[i] = (unsigned)(Rb * g.ldb + C) * 2u; }
    const size_t kstep = (size_t)(BK * 2), kstepA = g.ksA ? g.ksA : kstep;
    const size_t hsA = (size_t)HALF * g.lda * 2, hsB = (size_t)HALF * g.ldb * 2;
    const size_t tsA = g.tsA_ ? g.tsA_ : 2 * hsA, tsB = 2 * hsB;
    const unsigned ldsw = (unsigned)wid * 1024u;
    const int aoff = lds_byte(wr * 64 + fr, fq * 8), boff = lds_byte(wc * 32 + fr, fq * 8);
#define PG8_SA(b, h) (((b) * 2 + (h)) * HTB)
#define PG8_SB(b, h) ((4 + (b) * 2 + (h)) * HTB)
#define PG8_STAGE(bufoff, gbase, voff) do { _Pragma("unroll") for (int _i = 0; _i < 2; ++_i) \
        __builtin_amdgcn_global_load_lds((const unsigned*)((const char*)(gbase) + (voff)[_i]), (LAS unsigned*)(lds + (bufoff) + ldsw + _i * 8192), 16, 0, 0); } while (0)
#define PG8_LDA(dst, b, h) do { _Pragma("unroll") for (int m = 0; m < 4; ++m) _Pragma("unroll") for (int k = 0; k < 2; ++k) dst[m][k] = *(const LAS bf16x8*)(lds + PG8_SA(b, h) + aoff + m * 2048 + k * 1024); } while (0)
#define PG8_LDB(dst, b, h) do { _Pragma("unroll") for (int n = 0; n < 2; ++n) _Pragma("unroll") for (int k = 0; k < 2; ++k) dst[n][k] = *(const LAS bf16x8*)(lds + PG8_SB(b, h) + boff + n * 2048 + k * 1024); } while (0)
#define PG8_MMA(ai, bj, At, Bt) do { __builtin_amdgcn_s_setprio(1); _Pragma("unroll") for (int m = 0; m < 4; ++m) _Pragma("unroll") for (int n = 0; n < 2; ++n) _Pragma("unroll") for (int k = 0; k < 2; ++k) \
        acc[ai][bj][m][n] = __builtin_amdgcn_mfma_f32_16x16x32_bf16(Bt[n][k], At[m][k], acc[ai][bj][m][n], 0, 0, 0); __builtin_amdgcn_s_setprio(0); } while (0)
#define PG8_WAIT_V(n) asm volatile("s_waitcnt vmcnt(" #n ")" ::: "memory")
#define PG8_WAIT_L(n) asm volatile("s_waitcnt lgkmcnt(" #n ")" ::: "memory")
#define PG8_BAR __builtin_amdgcn_s_barrier()
#define PG8_SCHED __builtin_amdgcn_sched_barrier(0)
    Unit cur, nxt; int ui = 0;
    if (!S.next(0, cur)) return;
    f32x4 acc[2][2][4][2];
#pragma unroll
    for (int a = 0; a < 2; ++a)
#pragma unroll
        for (int b = 0; b < 2; ++b)
#pragma unroll
            for (int m = 0; m < 4; ++m)
#pragma unroll
                for (int n = 0; n < 2; ++n) acc[a][b][m][n] = (f32x4){0.f, 0.f, 0.f, 0.f};
    bf16x8 At[4][2], B0[2][2], B1[2][2];
    const char* cA = (const char*)g.A + (size_t)cur.pb * g.sA * 2 + (size_t)cur.pm * tsA; const char* cB = (const char*)g.Bt + (size_t)cur.pb * g.sB * 2 + (size_t)cur.pn * tsB;
    PG8_STAGE(PG8_SB(0, 0), cB, voffB); PG8_STAGE(PG8_SB(0, 1), cB + hsB, voffB); PG8_STAGE(PG8_SA(0, 0), cA, voffA); PG8_STAGE(PG8_SA(0, 1), cA + hsA, voffA);
    if (wr == 1) PG8_BAR;
    PG8_WAIT_V(2); PG8_BAR;
    PG8_STAGE(PG8_SB(1, 0), cB + kstep, voffB); PG8_STAGE(PG8_SA(1, 0), cA + kstepA, voffA); PG8_STAGE(PG8_SB(1, 1), cB + hsB + kstep, voffB);
    PG8_WAIT_V(6); PG8_BAR;
    for (;;) {
        const bool has_next = S.next(ui + 1, nxt);
        const char* nA = has_next ? (const char*)g.A + (size_t)nxt.pb * g.sA * 2 + (size_t)nxt.pm * tsA : cA; const char* nB = has_next ? (const char*)g.Bt + (size_t)nxt.pb * g.sB * 2 + (size_t)nxt.pn * tsB : cB;
        for (int t = 0; t < nt; t += 2) {
            const bool last = (t == nt - 2);
            const char* a1 = cA + (size_t)(t + 1) * kstepA;
            const char* a2 = last ? nA : cA + (size_t)(t + 2) * kstepA; const char* b2 = last ? nB : cB + (size_t)(t + 2) * kstep;
            const char* a3 = a2 + kstepA; const char* b3 = b2 + kstep;
            PG8_LDB(B0, 0, 0); PG8_LDB(B1, 0, 1); PG8_SCHED; PG8_LDA(At, 0, 0); PG8_STAGE(PG8_SA(1, 1), a1 + hsA, voffA);
            PG8_WAIT_V(8); PG8_WAIT_L(0); PG8_BAR; PG8_MMA(0, 0, At, B0); PG8_MMA(0, 1, At, B1); PG8_BAR; PG8_SCHED;
            PG8_LDA(At, 0, 1); PG8_STAGE(PG8_SB(0, 0), b2, voffB); PG8_STAGE(PG8_SB(0, 1), b2 + hsB, voffB); PG8_STAGE(PG8_SA(0, 0), a2, voffA);
            PG8_WAIT_V(8); PG8_WAIT_L(0); PG8_BAR; PG8_MMA(1, 0, At, B0); PG8_MMA(1, 1, At, B1); PG8_BAR; PG8_SCHED;
            PG8_LDB(B0, 1, 0); PG8_LDB(B1, 1, 1); PG8_SCHED; PG8_LDA(At, 1, 0); PG8_STAGE(PG8_SA(0, 1), a2 + hsA, voffA);
            PG8_WAIT_V(8); PG8_WAIT_L(0); PG8_BAR; PG8_MMA(0, 0, At, B0); PG8_MMA(0, 1, At, B1); PG8_BAR; PG8_SCHED;
            PG8_LDA(At, 1, 1); PG8_STAGE(PG8_SB(1, 0), b3, voffB); PG8_STAGE(PG8_SB(1, 1), b3 + hsB, voffB); PG8_STAGE(PG8_SA(1, 0), a3, voffA);
            PG8_WAIT_V(8); PG8_WAIT_L(0); PG8_BAR; PG8_MMA(1, 0, At, B0); PG8_MMA(1, 1, At, B1); PG8_BAR; PG8_SCHED;
        }
        if constexpr (ALIGN_EPI) { if (wr == 0) PG8_BAR; }
        E(acc, cur, wr, wc, fr, fq);
        if (!has_next) break;
#pragma unroll
        for (int a = 0; a < 2; ++a)
#pragma unroll
            for (int b = 0; b < 2; ++b)
#pragma unroll
                for (int m = 0; m < 4; ++m)
#pragma unroll
                    for (int n = 0; n < 2; ++n) acc[a][b][m][n] = (f32x4){0.f, 0.f, 0.f, 0.f};
        cur = nxt; cA = nA; cB = nB; ++ui;
        if constexpr (ALIGN_EPI) { if (wr == 1) PG8_BAR; }
    }
    PG8_WAIT_V(0);
    if constexpr (!ALIGN_EPI) { if (wr == 0) PG8_BAR; }
    PG8_BAR;
#undef PG8_SA
#undef PG8_SB
#undef PG8_STAGE
#undef PG8_LDA
#undef PG8_LDB
#undef PG8_MMA
#undef PG8_WAIT_V
#undef PG8_WAIT_L
#undef PG8_BAR
#undef PG8_SCHED
}
}

namespace attn_body {
using bf16=__hip_bfloat16;
using bf16x8=__attribute__((ext_vector_type(8)))short;
using s16x4=__attribute__((ext_vector_type(4)))short;
using f32x16=__attribute__((ext_vector_type(16)))float;
using u32x4=__attribute__((ext_vector_type(4)))unsigned;
constexpr int D=64,QP=512,KP=128;
constexpr int NW=8,QBLK=32,QB=QBLK*NW,KVBLK=64;
__device__ __forceinline__ int crow(int r,int hi){return (r&3)+8*(r>>2)+4*hi;}
#define SBAR() __builtin_amdgcn_sched_barrier(0)
constexpr int NSLOT=3, SLOTB=8192;
constexpr int LDS_K=0, LDS_V=NSLOT*SLOTB, LDS_WS=2*NSLOT*SLOTB, LDS_OST=LDS_WS+NW*64*4, LDS_BYTES=LDS_OST+NW*4096;
__device__ __forceinline__ void glds16(const void*gsrc,unsigned lds_dst){unsigned keep;
  asm volatile("s_mov_b32 %0, m0\n\ts_mov_b32 m0, %2\n\ts_nop 0\n\tglobal_load_lds_dwordx4 %1, off\n\ts_mov_b32 m0, %0":"=&s"(keep):"v"(gsrc),"s"(lds_dst):"memory");}
__device__ __forceinline__ float max3f(float a,float b,float c){float r;asm("v_max3_f32 %0, %1, %2, %3":"=v"(r):"v"(a),"v"(b),"v"(c));return r;}
__device__ __forceinline__ float max2f(float a,float b){float r;asm("v_max_f32_e32 %0, %1, %2":"=v"(r):"v"(a),"v"(b));return r;}
__device__ __forceinline__ float fadd_s(float a,float b){float r;asm("v_add_f32_e32 %0, %1, %2":"=v"(r):"v"(a),"v"(b));return r;}
__device__ __forceinline__ float fsub_s(float a,float b){float r;asm("v_sub_f32_e32 %0, %1, %2":"=v"(r):"v"(a),"v"(b));return r;}
typedef float f32x2_t __attribute__((ext_vector_type(2))); typedef __bf16 bf16x2_t __attribute__((ext_vector_type(2)));
__device__ __forceinline__ unsigned cvtpk_s(float lo,float hi){f32x2_t v={lo,hi};bf16x2_t b=__builtin_convertvector(v,bf16x2_t);return __builtin_bit_cast(unsigned,b);}
#define WAIT_BAR(N) asm volatile("s_waitcnt vmcnt(" #N ") lgkmcnt(0)\n\ts_barrier":::"memory")

__device__ __forceinline__ void qkt(f32x16&p0,f32x16&p1,const char*Kslot,const bf16x8*qr,const f32x16&negm,int r32,int hi){
  const char*kb=Kslot+hi*1024+r32*16;
  #pragma unroll
  for(int d0=0;d0<4;++d0){
    const bf16x8 b0=*reinterpret_cast<const bf16x8*>(kb+d0*2048);
    const bf16x8 b1=*reinterpret_cast<const bf16x8*>(kb+d0*2048+512);
    if(d0==0){p0=__builtin_amdgcn_mfma_f32_32x32x16_bf16(b0,qr[0],negm,0,0,0);p1=__builtin_amdgcn_mfma_f32_32x32x16_bf16(b1,qr[0],negm,0,0,0);}
    else{p0=__builtin_amdgcn_mfma_f32_32x32x16_bf16(b0,qr[d0],p0,0,0,0);p1=__builtin_amdgcn_mfma_f32_32x32x16_bf16(b1,qr[d0],p1,0,0,0);}}
}
typedef __attribute__((address_space(3))) const char* lds_cptr;
typedef short v4i16_t __attribute__((ext_vector_type(4)));
__device__ __forceinline__ void kload8(bf16x8*kf,lds_cptr kp){
  kf[0]=*(const __attribute__((address_space(3))) bf16x8*)(kp);      kf[1]=*(const __attribute__((address_space(3))) bf16x8*)(kp+512);
  kf[2]=*(const __attribute__((address_space(3))) bf16x8*)(kp+2048); kf[3]=*(const __attribute__((address_space(3))) bf16x8*)(kp+2560);
  kf[4]=*(const __attribute__((address_space(3))) bf16x8*)(kp+4096); kf[5]=*(const __attribute__((address_space(3))) bf16x8*)(kp+4608);
  kf[6]=*(const __attribute__((address_space(3))) bf16x8*)(kp+6144); kf[7]=*(const __attribute__((address_space(3))) bf16x8*)(kp+6656);
}
__device__ __forceinline__ void kload2(bf16x8*kf,lds_cptr kp,int j){ kf[2*j]=*(const __attribute__((address_space(3))) bf16x8*)(kp+j*2048); kf[2*j+1]=*(const __attribute__((address_space(3))) bf16x8*)(kp+j*2048+512); }
__device__ __forceinline__ s16x4 vtr(lds_cptr p){ return __builtin_bit_cast(s16x4,__builtin_amdgcn_ds_read_tr16_b64_v4i16((__attribute__((address_space(3))) v4i16_t*)p)); }
__device__ __forceinline__ float rowmax(const f32x16&p0,const f32x16&p1){
  float a=max3f(p0[0],p0[1],p1[0]),b=max3f(p0[2],p0[3],p1[1]);a=max3f(a,p1[2],p1[3]);
  #pragma unroll
  for(int r=4;r<16;r+=4){a=max3f(a,p0[r],p0[r+1]);b=max3f(b,p0[r+2],p0[r+3]);a=max3f(a,p1[r],p1[r+1]);b=max3f(b,p1[r+2],p1[r+3]);}
  const float m=max2f(a,b);
  auto rr=__builtin_amdgcn_permlane32_swap(__float_as_uint(m),__float_as_uint(m),false,false);
  return max2f(__uint_as_float(rr[0]),__uint_as_float(rr[1]));
}
__device__ __forceinline__ void pv(f32x16*o,int vb,bf16x8 pa0,bf16x8 pa1,bf16x8 pa2,bf16x8 pa3){
  #pragma unroll
  for(int d0=0;d0<2;++d0){s16x4 lo[4],hi[4];
    #pragma unroll
    for(int ks=0;ks<4;++ks){
      asm volatile("ds_read_b64_tr_b16 %0,%1 offset:%c2":"=&v"(lo[ks]):"v"(vb),"i"(d0*4096+ks*1024):"memory");
      asm volatile("ds_read_b64_tr_b16 %0,%1 offset:%c2":"=&v"(hi[ks]):"v"(vb),"i"(d0*4096+ks*1024+512):"memory");}
    asm volatile("s_waitcnt lgkmcnt(0)":::"memory");SBAR();
    #define PK(k) (bf16x8){lo[k][0],lo[k][1],lo[k][2],lo[k][3],hi[k][0],hi[k][1],hi[k][2],hi[k][3]}
    o[d0]=__builtin_amdgcn_mfma_f32_32x32x16_bf16(pa0,PK(0),o[d0],0,0,0);
    o[d0]=__builtin_amdgcn_mfma_f32_32x32x16_bf16(pa1,PK(1),o[d0],0,0,0);
    o[d0]=__builtin_amdgcn_mfma_f32_32x32x16_bf16(pa2,PK(2),o[d0],0,0,0);
    o[d0]=__builtin_amdgcn_mfma_f32_32x32x16_bf16(pa3,PK(3),o[d0],0,0,0);
    #undef PK
  }
}
#define ATTN_STORE16(p,v) (*(u32x4*)(p)=(v))
template<int THRL> __device__ __forceinline__ void attn_unit(int b,int h,int qb,const bf16*Q,const bf16*__restrict__ K,const bf16*__restrict__ V,bf16*O,char*shm,float m2){
  const int tid=threadIdx.x,lane=tid&63,r32=lane&31,hi=lane>>5; const int wid=__builtin_amdgcn_readfirstlane(tid>>6);
  const long rowbase=(long)b*SEQ; const int q0=qb*QB; const int kvh=h>>2;
  const bf16*Qw=Q+(rowbase+q0+wid*QBLK)*QP+h*D;
  const bf16*Kh=K+rowbase*KP+kvh*D,*Vh=V+rowbase*KP+kvh*D;
  const unsigned lds0=(unsigned)(uintptr_t)shm;
  float*wsf=(float*)(shm+LDS_WS)+wid*64;
  const bf16*ksrc=Kh+(long)lane*KP+wid*8;
  const bf16*vsrc=Vh+(long)(16*(wid&3)+(lane>>2))*KP+(wid>>2)*32+(lane&3)*8;
  const unsigned kdst=lds0+LDS_K+wid*1024, vdst=lds0+LDS_V+wid*1024;
  #define DMA_K(t,slot) glds16(ksrc+(long)(t)*KVBLK*KP,(unsigned)__builtin_amdgcn_readfirstlane(kdst+(slot)))
  #define DMA_V(t,slot) glds16(vsrc+(long)(t)*KVBLK*KP,(unsigned)__builtin_amdgcn_readfirstlane(vdst+(slot)))
  const int vb0=(int)(lds0+LDS_V)+((lane>>4)&1)*32+(lane&3)*8+(4*hi+((lane&15)>>2))*64;
  const char*Kbase=shm+LDS_K; bf16x8 kf[8];
  const lds_cptr shm3=(lds_cptr)shm; const lds_cptr kp0=shm3+LDS_K+hi*1024+r32*16; const lds_cptr vp0=shm3+LDS_V+((lane>>4)&1)*32+(lane&3)*8+(4*hi+((lane&15)>>2))*64;
  constexpr int NT=SEQ/KVBLK;
  DMA_K(0,0);DMA_V(0,0);DMA_K(1,SLOTB);
  bf16x8 qr[4];
  #pragma unroll
  for(int d0=0;d0<4;++d0)qr[d0]=*reinterpret_cast<const bf16x8*>(&Qw[(long)r32*QP+d0*16+hi*8]);
  float l_reg=0.f;f32x16 o[2];o[0]=f32x16{};o[1]=f32x16{};f32x16 negm;
  _Pragma("unroll") for(int r=0;r<16;++r)negm[r]=-m2;
  asm volatile("":"+v"(negm));
  #define START(P0,P1) do{ _Pragma("unroll") for(int r=0;r<16;++r)P0[r]=__builtin_amdgcn_exp2f(P0[r]); }while(0)
  #define RESC() do{}while(0)
  f32x16 pA0,pA1,pB0,pB1;
  int sl_prev=0,sl_cur=0,sl_next=SLOTB;
  #define ROT() do{sl_prev=sl_cur;sl_cur=sl_next;sl_next=(sl_next==(NSLOT-1)*SLOTB)?0:sl_next+SLOTB;}while(0)
  DMA_K(2,2*SLOTB);
  WAIT_BAR(3);
  qkt(pA0,pA1,Kbase,qr,negm,r32,hi);asm volatile("s_nop 15\n\ts_nop 7":"+v"(pA0),"+v"(pA1));
  START(pA0,pA1);
  _Pragma("unroll") for(int r=0;r<16;++r)pA1[r]=__builtin_amdgcn_exp2f(pA1[r]);
  WAIT_BAR(0);
  DMA_K(3,0);DMA_V(1,SLOTB);
  ROT();
  kload8(kf,kp0+sl_cur);
  WAIT_BAR(2);
  s16x4 vlo[8],vhi[8]; u32x4 pw0,pw1,pw2,pw3;
  #define PKW(P,B) cvtpk_s(P[B],P[B+1])
  #define PAF(k) __builtin_bit_cast(bf16x8,pw##k)
  #define VFR(i) (bf16x8){vlo[i][0],vlo[i][1],vlo[i][2],vlo[i][3],vhi[i][0],vhi[i][1],vhi[i][2],vhi[i][3]}
  #define PIN(x) asm volatile("":"+v"(x))
  #define MX3(a,b,c) __builtin_fmaxf(__builtin_fmaxf((a),(b)),(c))
  #define GAPA(MF,A0,A1,A2,A3,W0,W1,PW) do{ MF; sacc+=A0; sacc+=A1; sacc+=A2; sacc+=A3; PIN(sacc); W0; W1; PIN(PW); SBAR(); }while(0)
  #define EX(v) __builtin_amdgcn_exp2f(v)
  #define GAPB(MF,X,B) do{ MF; X[B]=EX(X[B]); X[B+1]=EX(X[B+1]); X[B+2]=EX(X[B+2]); X[B+3]=EX(X[B+3]); PIN(X); SBAR(); }while(0)
  #define VRD(i) do{ vlo[i]=vtr(vp_+(((i)>>2)*4096+((i)&3)*1024)); vhi[i]=vtr(vp_+(((i)>>2)*4096+((i)&3)*1024+512)); }while(0)
  #define KRD(G,j) do{ if(G){ kload2(kf,kp0+sl_next,j); SBAR(); } }while(0)
  #define STEP(C0,C1,P0,P1,t,GK,GV,GL) do{ SBAR(); \
    const lds_cptr vp_=vp0+sl_prev; \
    VRD(0); SBAR(); float sacc=(P0[0]+P0[1]); \
    GAPA(C0=__builtin_amdgcn_mfma_f32_32x32x16_bf16(kf[0],qr[0],negm,0,0,0), P0[2],P0[3],P0[4],P0[5],     pw0[0]=PKW(P0,0), pw0[1]=PKW(P0,2), pw0); \
    VRD(4); SBAR(); GAPA(C1=__builtin_amdgcn_mfma_f32_32x32x16_bf16(kf[1],qr[0],negm,0,0,0), P0[6],P0[7],P0[8],P0[9],     pw0[2]=PKW(P0,4), pw0[3]=PKW(P0,6), pw0); \
    VRD(1); SBAR(); GAPA(C0=__builtin_amdgcn_mfma_f32_32x32x16_bf16(kf[2],qr[1],C0,0,0,0),   P0[10],P0[11],P0[12],P0[13], pw1[0]=PKW(P0,8), pw1[1]=PKW(P0,10), pw1); \
    VRD(5); SBAR(); GAPA(C1=__builtin_amdgcn_mfma_f32_32x32x16_bf16(kf[3],qr[1],C1,0,0,0),   P0[14],P0[15],P1[0],P1[1],   pw1[2]=PKW(P0,12),pw1[3]=PKW(P0,14), pw1); \
    VRD(2); SBAR(); GAPA(C0=__builtin_amdgcn_mfma_f32_32x32x16_bf16(kf[4],qr[2],C0,0,0,0),   P1[2],P1[3],P1[4],P1[5],     pw2[0]=PKW(P1,0), pw2[1]=PKW(P1,2), pw2); \
    VRD(6); SBAR(); GAPA(C1=__builtin_amdgcn_mfma_f32_32x32x16_bf16(kf[5],qr[2],C1,0,0,0),   P1[6],P1[7],P1[8],P1[9],     pw2[2]=PKW(P1,4), pw2[3]=PKW(P1,6), pw2); \
    VRD(3); SBAR(); GAPA(C0=__builtin_amdgcn_mfma_f32_32x32x16_bf16(kf[6],qr[3],C0,0,0,0),   P1[10],P1[11],P1[12],P1[13], pw3[0]=PKW(P1,8), pw3[1]=PKW(P1,10), pw3); \
    VRD(7); SBAR(); GAPA(C1=__builtin_amdgcn_mfma_f32_32x32x16_bf16(kf[7],qr[3],C1,0,0,0),   P1[14],P1[15],0.f,0.f,       pw3[2]=PKW(P1,12),pw3[3]=PKW(P1,14), pw3); \
    l_reg+=sacc; \
    if(GK){DMA_K((t)+3,sl_cur);} if(GV){DMA_V((t)+1,sl_next);} \
    SBAR(); \
    GAPB(o[0]=__builtin_amdgcn_mfma_f32_32x32x16_bf16(PAF(0),VFR(0),o[0],0,0,0), C0,0); \
    GAPB(o[1]=__builtin_amdgcn_mfma_f32_32x32x16_bf16(PAF(0),VFR(4),o[1],0,0,0), C0,4); \
    KRD(GL,0); GAPB(o[0]=__builtin_amdgcn_mfma_f32_32x32x16_bf16(PAF(1),VFR(1),o[0],0,0,0), C0,8); \
    KRD(GL,1); GAPB(o[1]=__builtin_amdgcn_mfma_f32_32x32x16_bf16(PAF(1),VFR(5),o[1],0,0,0), C0,12); \
    KRD(GL,2); GAPB(o[0]=__builtin_amdgcn_mfma_f32_32x32x16_bf16(PAF(2),VFR(2),o[0],0,0,0), C1,0); \
    KRD(GL,3); GAPB(o[1]=__builtin_amdgcn_mfma_f32_32x32x16_bf16(PAF(2),VFR(6),o[1],0,0,0), C1,4); \
    GAPB(o[0]=__builtin_amdgcn_mfma_f32_32x32x16_bf16(PAF(3),VFR(3),o[0],0,0,0), C1,8); \
    GAPB(o[1]=__builtin_amdgcn_mfma_f32_32x32x16_bf16(PAF(3),VFR(7),o[1],0,0,0), C1,12); \
    }while(0)
  int t=1;
  for(;t+5<NT;t+=2){
    STEP(pB0,pB1,pA0,pA1,t,true,true,true);     WAIT_BAR(2); RESC(); ROT();
    STEP(pA0,pA1,pB0,pB1,t+1,true,true,true);   WAIT_BAR(2); RESC(); ROT();
  }
  #define ENDW(tt) do{ if((tt)+3<NT){WAIT_BAR(2);} else if((tt)+2<NT){WAIT_BAR(1);} else {WAIT_BAR(0);} }while(0)
  for(;t+1<NT;t+=2){
    STEP(pB0,pB1,pA0,pA1,t,(t+3<NT),(t+1<NT),(t+1<NT));       ENDW(t);   RESC(); ROT();
    STEP(pA0,pA1,pB0,pB1,t+1,(t+4<NT),(t+2<NT),(t+2<NT));     ENDW(t+1); RESC(); ROT();
  }
  STEP(pB0,pB1,pA0,pA1,NT-1,false,false,false); RESC();
  { float sacc=pB0[0]+pB0[1]; _Pragma("unroll") for(int r=2;r<16;++r)sacc+=pB0[r]; _Pragma("unroll") for(int r=0;r<16;++r)sacc+=pB1[r]; l_reg+=sacc;
    pw0=(u32x4){PKW(pB0,0),PKW(pB0,2),PKW(pB0,4),PKW(pB0,6)};pw1=(u32x4){PKW(pB0,8),PKW(pB0,10),PKW(pB0,12),PKW(pB0,14)};pw2=(u32x4){PKW(pB1,0),PKW(pB1,2),PKW(pB1,4),PKW(pB1,6)};pw3=(u32x4){PKW(pB1,8),PKW(pB1,10),PKW(pB1,12),PKW(pB1,14)};
    SBAR(); pv(o,vb0+sl_cur,PAF(0),PAF(1),PAF(2),PAF(3)); }
  #undef PKW
  #undef PAF
  #undef VFR
  #undef PIN
  #undef MX3
  #undef GAPA
  #undef GAPB
  #undef EX
  #undef VRD
  #undef KRD
  #undef STEP
  #undef ENDW
  {auto rr=__builtin_amdgcn_permlane32_swap(__float_as_uint(l_reg),__float_as_uint(l_reg),false,false);l_reg=__uint_as_float(rr[0])+__uint_as_float(rr[1]);}
  if(hi==0)wsf[32+r32]=l_reg;asm volatile("s_waitcnt lgkmcnt(0)":::"memory");
  float rli[16];
  #pragma unroll
  for(int r=0;r<16;++r)rli[r]=__builtin_amdgcn_rcpf(wsf[32+crow(r,hi)]);
  bf16*Ow=O+(rowbase+q0+wid*QBLK)*QP+h*D;
  { bf16*stg=(bf16*)(shm+LDS_OST)+wid*2048;
    #pragma unroll
    for(int r=0;r<16;++r){const int orow=crow(r,hi);
      #pragma unroll
      for(int d0=0;d0<2;++d0)stg[orow*64+d0*32+r32]=__float2bfloat16(o[d0][r]*rli[r]);}
    asm volatile("s_waitcnt lgkmcnt(0)":::"memory");
    #pragma unroll
    for(int i=0;i<4;++i){const int row=i*8+(lane>>3),ch=lane&7; const u32x4 v=*(const u32x4*)(stg+row*64+ch*8); ATTN_STORE16(Ow+(long)row*QP+ch*8,v);} }
  asm volatile("s_waitcnt lgkmcnt(0)\n\ts_barrier":::"memory");
  #undef DMA_K
  #undef DMA_V
  #undef START
  #undef RESC
  #undef ROT
}
constexpr int ATTN_LDS_BYTES=LDS_BYTES;
#undef SBAR
#undef WAIT_BAR
}

constexpr int NWAVES = 8;
constexpr size_t MiB = 1u << 20;
constexpr size_t WS_SS = 0;
constexpr size_t WS_WGLU = 1 * MiB, WS_WPP = 1 * MiB + 512 * 1024, WS_WAB = 2 * MiB, WS_WSB = 3 * MiB, WS_WOUT = 4 * MiB, WS_WPG = 6 * MiB;
constexpr size_t WS_WIN = 8 * MiB, WS_W1GU = 15 * MiB, WS_W1D = 26 * MiB, WS_W2GU = 32 * MiB, WS_W2D = 43 * MiB;
constexpr size_t WS_WEND = 49 * MiB, WS_WBIG = 53 * MiB, WS_PB = 61 * MiB, WS_XB = 69 * MiB;
constexpr size_t WS_ACT = 101 * MiB;
constexpr size_t WS_Q = 101 * MiB, WS_K = 117 * MiB, WS_V = 121 * MiB, WS_GATES = 125 * MiB, WS_AUG = 189 * MiB, WS_E = 221 * MiB;
constexpr size_t WS_Z = 221 * MiB, WS_Z2 = 237 * MiB, WS_MG = 189 * MiB, WS_CTL = 253 * MiB, CTL_BYTES = 65536, WS_END = 254 * MiB;
constexpr int RING_BYTES = 131072, MISC_OFF = RING_BYTES + 320, LDS_BYTES = 147456;

typedef unsigned short bf16;
typedef float f32x4 __attribute__((ext_vector_type(4)));
typedef unsigned v4u __attribute__((ext_vector_type(4)));
typedef unsigned v2u __attribute__((ext_vector_type(2)));
#define LDS_WAIT() asm volatile("s_waitcnt lgkmcnt(0)" ::: "memory")
__device__ __forceinline__ unsigned f2bf(float f) { unsigned u = __builtin_bit_cast(unsigned, f); return (u + 0x7fffu + ((u >> 16) & 1u)) >> 16; }
__device__ __forceinline__ unsigned pk2(float lo, float hi) { return f2bf(lo) | (f2bf(hi) << 16); }
__device__ __forceinline__ float wave_sum(float v) {
#pragma unroll
    for (int o = 1; o < 64; o <<= 1) v += __shfl_xor(v, o);
    return v;
}
__device__ __forceinline__ void p0_transpose_item(const float* W, int K, int N, bf16* WT, const float* gain, int mode, LAS float* scr, int item, int lane) {
    const int nblk = N / 64, kb = item / nblk, nb = item % nblk, k0 = 64 * kb, n00 = 64 * nb;
    f32x4 w[2][8]; float gn[8];
#pragma unroll
    for (int hf = 0; hf < 2; ++hf)
#pragma unroll
        for (int i = 0; i < 8; ++i) w[hf][i] = __builtin_nontemporal_load((const f32x4*)(W + (size_t)(k0 + (lane >> 3) + 8 * i) * N + n00 + 32 * hf + 4 * (lane & 7)));
#pragma unroll
    for (int i = 0; i < 8; ++i) gn[i] = gain ? gain[k0 + (lane >> 3) + 8 * i] : 1.0f;
#pragma unroll
    for (int hf = 0; hf < 2; ++hf) { const int n0 = n00 + 32 * hf;
#pragma unroll
      for (int i = 0; i < 8; ++i) { const int kk = (lane >> 3) + 8 * i; LAS float* d = scr + kk * 33 + 4 * (lane & 7);
          d[0] = w[hf][i].x * gn[i]; d[1] = w[hf][i].y * gn[i]; d[2] = w[hf][i].z * gn[i]; d[3] = w[hf][i].w * gn[i]; }
    LDS_WAIT(); asm volatile("" ::: "memory");
    const int c = lane & 7;
#pragma unroll
    for (int j = 0; j < 4; ++j) { const int n = (lane >> 3) + 8 * j; const LAS float* s = scr + (8 * c) * 33 + n;
        v4u o; o.x = pk2(s[0 * 33], s[1 * 33]); o.y = pk2(s[2 * 33], s[3 * 33]); o.z = pk2(s[4 * 33], s[5 * 33]); o.w = pk2(s[6 * 33], s[7 * 33]);
        const int ng = n0 + n; int row;
        if (mode == 0) row = ng;
        else if (mode == 3) {
            if (ng < 512) row = (ng & ~255) + 128 * ((ng >> 5) & 1) + 32 * ((ng >> 6) & 3) + (ng & 31);
            else if (ng < 640) row = 512 + 128 * ((ng >> 5) & 1) + 32 * ((ng >> 6) & 1) + (ng & 31);
            else if (ng < 768) { const int vi = ng - 640; row = 512 + 128 * ((vi >> 5) & 1) + 32 * (2 + (vi >> 6)) + (vi & 31); }
            else row = ng; }
        else row = (ng >> 7) * 256 + (ng & 127) + (mode == 2 ? 128 : 0);
        *(v4u*)(WT + (size_t)row * K + k0 + 8 * c) = o; }
    LDS_WAIT(); asm volatile("" ::: "memory"); }
}
struct cplx { float re, im; };
__device__ __forceinline__ cplx cmul(cplx a, cplx b) { return cplx{a.re * b.re - a.im * b.im, a.re * b.im + a.im * b.re}; }
__device__ __forceinline__ void sincos_rev(float rev, float& s, float& c) { const float f = rev - floorf(rev); s = __builtin_amdgcn_sinf(f); c = __builtin_amdgcn_cosf(f); }

__device__ __forceinline__ void s5_gen(LAS unsigned char* lds, int g, int part, int tid, const float* lam_re, const float* lam_im, const float* log_step, const float* b_re, const float* b_im,
                                       const float* c_re, const float* c_im, const float* dskip, bf16* Wend, bf16* Wbig) {
    LAS float* L = (LAS float*)lds;
    LAS float* Bb = L + 2 * 17 * 64 * 2;
    LAS float* Cc = Bb + 2 * 1024 * 2;
    LAS float* Kt = Cc + 2 * 1024 * 2;
    for (int idx = tid; idx < 2 * 17 * 64; idx += 512) { const int dir = idx / (17 * 64), j = (idx / 64) % 17, p = idx & 63;
        const float lr = lam_re[(dir * 32 + g) * 64 + p], li = lam_im[(dir * 32 + g) * 64 + p], delta = expf(log_step[dir * 32 + g]);
        const float mag = expf((float)j * delta * lr); float s, c; sincos_rev((float)j * delta * li * 0.15915494309189535f, s, c);
        L[idx * 2] = mag * c; L[idx * 2 + 1] = mag * s; }
    for (int idx = tid; idx < 2 * 1024; idx += 512) { const int dir = idx >> 10, r = idx & 1023;
        { const int p = r >> 4; const float lr = lam_re[(dir * 32 + g) * 64 + p], li = lam_im[(dir * 32 + g) * 64 + p], delta = expf(log_step[dir * 32 + g]);
          const float mag = expf(delta * lr); float s, c; sincos_rev(delta * li * 0.15915494309189535f, s, c);
          const float nr = mag * c - 1.0f, ni = mag * s, den = 1.0f / (lr * lr + li * li);
          const cplx coef{(nr * lr + ni * li) * den, (ni * lr - nr * li) * den};
          const size_t src = ((size_t)(dir * 32 + g) * 64) * 16 + r;
          const cplx bb = cmul(coef, cplx{b_re[src], b_im[src]});
          Bb[idx * 2] = bb.re; Bb[idx * 2 + 1] = bb.im; }
        { const size_t src = ((size_t)(dir * 32 + g) * 16) * 64 + r;
          Cc[idx * 2] = c_re[src]; Cc[idx * 2 + 1] = c_im[src]; } }
    __syncthreads();
    { const int dir = tid >> 8, h = (tid >> 4) & 15, h2 = tid & 15; float acc[16];
#pragma unroll
      for (int j = 0; j < 16; ++j) acc[j] = 0.f;
      for (int p = 0; p < 64; ++p) { const cplx cc{Cc[((dir * 16 + h) * 64 + p) * 2], Cc[((dir * 16 + h) * 64 + p) * 2 + 1]}, bb{Bb[((dir * 64 + p) * 16 + h2) * 2], Bb[((dir * 64 + p) * 16 + h2) * 2 + 1]};
          const cplx cb = cmul(cc, bb);
#pragma unroll
          for (int j = 0; j < 16; ++j) { const float lr = L[((dir * 17 + j) * 64 + p) * 2], li = L[((dir * 17 + j) * 64 + p) * 2 + 1]; acc[j] += cb.re * lr - cb.im * li; } }
#pragma unroll
      for (int j = 0; j < 16; ++j) Kt[(dir * 16 + j) * 256 + h * 16 + h2] = acc[j]; }
    __syncthreads();
    for (int e = tid; e < 64 * 256; e += 512) { const int n = 64 * part + (e >> 8), kp = e & 255, tl = n >> 4, h = n & 15; float v[2];
#pragma unroll
        for (int s = 0; s < 2; ++s) { const int k = 2 * kp + s; float val;
            if (k < 256) { const int tl2 = k >> 4, h2 = k & 15; val = 0.f;
                if (tl2 <= tl) val += Kt[(0 * 16 + (tl - tl2)) * 256 + h * 16 + h2];
                if (tl2 >= tl) val += Kt[(1 * 16 + (tl2 - tl)) * 256 + h * 16 + h2];
                if (k == n) val += dskip[g * 16 + h]; }
            else { const int kk = k - 256, dir = kk >> 7, part = (kk >> 6) & 1, p = kk & 63, ex = dir ? 16 - tl : tl + 1;
                const cplx cc{Cc[((dir * 16 + h) * 64 + p) * 2], Cc[((dir * 16 + h) * 64 + p) * 2 + 1]}, ll{L[((dir * 17 + ex) * 64 + p) * 2], L[((dir * 17 + ex) * 64 + p) * 2 + 1]};
                const cplx x = cmul(cc, ll); val = part ? -x.im : x.re; }
            v[s] = val; }
        *(unsigned*)(Wbig + ((size_t)g * 256 + n) * 512 + 2 * kp) = pk2(v[0], v[1]); }
    for (int e = tid; e < 64 * 128; e += 512) { const int n = 64 * part + (e >> 7), kp = e & 127, dir = n >> 7, prt = (n >> 6) & 1, p = n & 63; float v[2];
#pragma unroll
        for (int s = 0; s < 2; ++s) { const int k = 2 * kp + s, tl = k >> 4, h = k & 15, ex = dir ? tl : 15 - tl;
            const cplx ll{L[((dir * 17 + ex) * 64 + p) * 2], L[((dir * 17 + ex) * 64 + p) * 2 + 1]}, bb{Bb[((dir * 64 + p) * 16 + h) * 2], Bb[((dir * 64 + p) * 16 + h) * 2 + 1]};
            const cplx x = cmul(ll, bb); v[s] = prt ? x.im : x.re; }
        *(unsigned*)(Wend + ((size_t)g * 256 + n) * 256 + 2 * kp) = pk2(v[0], v[1]); }
    __syncthreads();
}

#define XB_TMO      128
#define XB_XCNT(j)  (256  + 64 * (j))
#define XB_XSUB(j)  (1280 + 64 * (j))
#define XB_XGEN(j)  (2304 + 64 * (j))
#define XB_TOP      3328
#define XB_TOPGEN   3392
#define XCD_BAR_WORDS 3456
#define XB_SPIN_CAP (1u << 18)
__device__ __forceinline__ unsigned xb_ld(unsigned* p)              { return __hip_atomic_load(p, __ATOMIC_RELAXED, __HIP_MEMORY_SCOPE_AGENT); }
__device__ __forceinline__ unsigned xb_add(unsigned* p, unsigned v) { return __hip_atomic_fetch_add(p, v, __ATOMIC_RELAXED, __HIP_MEMORY_SCOPE_AGENT); }
__device__ __forceinline__ unsigned xb_xcc_id() { return (unsigned)__builtin_amdgcn_s_getreg((3 << 11) | 20) & 0xFu; }
#define XB_SPIN(cond, bar) do { unsigned _sp = 0; while (cond) { __builtin_amdgcn_s_sleep(1); \
    if ((++_sp & 255u) == 0u) { if (xb_ld(&(bar)[XB_TMO])) break; if (_sp > XB_SPIN_CAP) { atomicAdd(&(bar)[XB_TMO], 1u); break; } } } } while (0)
struct XcdBarrier { unsigned* bar; unsigned x; volatile LAS unsigned* st; };
__device__ __forceinline__ XcdBarrier xcd_barrier_post(unsigned* bar, volatile LAS unsigned* st) {
    XcdBarrier b; b.bar = bar; b.x = xb_xcc_id(); b.st = st;
    if (threadIdx.x == 0) (void)xb_add(&bar[XB_XCNT(b.x)], 1u);
    return b;
}
__device__ __forceinline__ void xcd_barrier_complete(unsigned* bar, unsigned x, unsigned& nloc, unsigned& nx) {
    const unsigned G = gridDim.x * gridDim.y * gridDim.z;
    unsigned sum, cnt, mine, sp = 0u;
    for (;;) {
        sum = 0u; cnt = 0u; mine = 0u;
#pragma unroll
        for (unsigned j = 0; j < 16; ++j) { const unsigned c = xb_ld(&bar[XB_XCNT(j)]); sum += c; cnt += (c > 0u) ? 1u : 0u; mine = (j == x) ? c : mine; }
        if (sum == G) break;
        __builtin_amdgcn_s_sleep(1);
        if ((++sp & 255u) == 0u) { if (xb_ld(&bar[XB_TMO])) break; if (sp > XB_SPIN_CAP) { atomicAdd(&bar[XB_TMO], 1u); break; } }
    }
    nloc = mine > 0u ? mine : 1u; nx = cnt > 0u ? cnt : 1u;
}
__device__ __forceinline__ void xcd_barrier(const XcdBarrier& b) {
    asm volatile("s_waitcnt vmcnt(0)" ::: "memory");
    __syncthreads();
    if (threadIdx.x == 0) {
        unsigned* bar = b.bar;
        __builtin_amdgcn_s_waitcnt(0);
        unsigned nloc = b.st[0], nx = b.st[1];
        if (nloc == 0u) { xcd_barrier_complete(bar, b.x, nloc, nx); b.st[0] = nloc; b.st[1] = nx; }
        const unsigned old = xb_add(&bar[XB_XSUB(b.x)], 1u);
        const unsigned gen = old / nloc;
        if (old + 1u == (gen + 1u) * nloc) {
            __builtin_amdgcn_fence(__ATOMIC_RELEASE, "agent");
            asm volatile("s_waitcnt vmcnt(0)" ::: "memory");
            const unsigned og = xb_add(&bar[XB_TOP], 1u);
            const unsigned tg = og / nx;
            if (og + 1u == (tg + 1u) * nx) xb_add(&bar[XB_TOPGEN], 1u);
            else XB_SPIN(xb_ld(&bar[XB_TOPGEN]) == tg, bar);
            __builtin_amdgcn_fence(__ATOMIC_ACQUIRE, "agent");
            xb_add(&bar[XB_XGEN(b.x)], 1u);
            asm volatile("s_waitcnt vmcnt(0)" ::: "memory");
        } else {
            XB_SPIN(xb_ld(&bar[XB_XGEN(b.x)]) == gen, bar);
            __builtin_amdgcn_fence(__ATOMIC_ACQUIRE, "agent");
            asm volatile("s_waitcnt vmcnt(0)" ::: "memory");
        }
    }
    __syncthreads();
}

struct Args { const float* in[30]; float* out; unsigned char* ws; int ph_lo, ph_hi; };
constexpr int N_PHASES = 13;

__global__ void __launch_bounds__(NWAVES * 64, 2) mega_fwd(Args args) {
    __builtin_assume(__builtin_amdgcn_workitem_id_y() == 0); __builtin_assume(__builtin_amdgcn_workitem_id_z() == 0);
    extern __shared__ __attribute__((aligned(16))) unsigned char lds_raw[];
    LAS unsigned char* lds = (LAS unsigned char*)lds_raw;
    cg::grid_group grid = cg::this_grid();
#define OPAQUE_TID() int tid = threadIdx.x; asm volatile("" : "+v"(tid)); const int lane = tid & 63; const int wave = __builtin_amdgcn_readfirstlane(tid >> 6); (void)lane; (void)wave
    const int G = gridDim.x;
    unsigned char* ws = args.ws;
    int bx;
    { volatile LAS unsigned* vb = (volatile LAS unsigned*)(lds + MISC_OFF + 96);
      if (threadIdx.x == 0) { unsigned v = blockIdx.x;
          if (G == 256) { const unsigned xcc = xb_xcc_id() & 7u; const unsigned slot = xb_add((unsigned*)(ws + WS_CTL) + 6144 + 64 * xcc, 1u); v = (slot & 31u) * 8u + xcc; }
          vb[0] = v; }
      __syncthreads(); bx = (int)__builtin_amdgcn_readfirstlane(vb[0]); __syncthreads(); }
    const int vcu = (G % 8 == 0) ? (bx % 8) * (G / 8) + bx / 8 : bx;
    const float* x = args.in[0]; float* out = args.out;
    float* ss0 = (float*)(ws + WS_SS); float* ss1 = ss0 + M; float* ss2 = ss1 + M; float* ss3 = ss2 + M;
    bf16* Wglu = (bf16*)(ws + WS_WGLU); bf16* Wpp = (bf16*)(ws + WS_WPP); bf16* Wab = (bf16*)(ws + WS_WAB); bf16* Wsb = (bf16*)(ws + WS_WSB); bf16* Wout = (bf16*)(ws + WS_WOUT); bf16* Wpg = (bf16*)(ws + WS_WPG);
    bf16* Win = (bf16*)(ws + WS_WIN); bf16* W1gu = (bf16*)(ws + WS_W1GU); bf16* W1d = (bf16*)(ws + WS_W1D); bf16* W2gu = (bf16*)(ws + WS_W2GU); bf16* W2d = (bf16*)(ws + WS_W2D);
    bf16* Wend = (bf16*)(ws + WS_WEND); bf16* Wbig = (bf16*)(ws + WS_WBIG); bf16* PB = (bf16*)(ws + WS_PB); bf16* XB = (bf16*)(ws + WS_XB);
    bf16* ACT = (bf16*)(ws + WS_ACT); bf16* QB_ = (bf16*)(ws + WS_Q); bf16* KB = (bf16*)(ws + WS_K); bf16* VB = (bf16*)(ws + WS_V); bf16* GATES = (bf16*)(ws + WS_GATES);
    bf16* AUG = (bf16*)(ws + WS_AUG); float* EB = (float*)(ws + WS_E); bf16* ZB = (bf16*)out; bf16* Z2B = (bf16*)out + (size_t)M * 512;     bf16* MG = (bf16*)(ws + WS_MG); bf16* PTMP = (bf16*)(ws + WS_AUG);

    const int lo = args.ph_lo, hi = args.ph_hi;
    volatile LAS unsigned* MISC = (volatile LAS unsigned*)(lds + MISC_OFF);
    if (threadIdx.x < 32) MISC[threadIdx.x] = 0u;
    __syncthreads();
    XcdBarrier bar = xcd_barrier_post((unsigned*)(ws + WS_CTL), MISC + 8);
#define IN(k) (lo <= (k) && (k) < hi)
#define SEAM(k) do { if (IN(k) && IN((k) + 1)) xcd_barrier(bar); } while (0)
    if (lo < 0) grid.sync();

    if (IN(0)) {
        OPAQUE_TID();
        const int gw = vcu * NWAVES + wave, NGW = G * NWAVES;
        LAS float* scr = (LAS float*)(lds + wave * 16384);
        constexpr int I_GU = (DM / 64) * (FF / 64), I_D = (FF / 64) * (DM / 64), I_IN = (DM / 64) * (NIN / 64), I_GLU = (512 / 64) * (512 / 64), I_BR = (512 / 64) * (DM / 64), I_SQ = (DM / 64) * (DM / 64), I_PP = (PLE / 64) * (DM / 64);
        for (int it = gw; it < 2 * I_GU; it += NGW) {
            if (it < I_GU) p0_transpose_item(args.in[3], DM, FF, W1gu, args.in[2], 1, scr, it, lane);
            else p0_transpose_item(args.in[4], DM, FF, W1gu, args.in[2], 2, scr, it - I_GU, lane);
        }
        { const int rbase = (G == 256) ? 2048 * (bx & 7) + 64 * (bx >> 3) : -1;
          if (rbase >= 0) {
#pragma unroll 1
            for (int it = 0; it < 2; ++it) { const int m = rbase + wave * 8 + 4 * it; const f32x4* xr = (const f32x4*)(x + (size_t)m * DM) + lane; f32x4 v[16]; float sq[4] = {0.f, 0.f, 0.f, 0.f};
#pragma unroll
                for (int j = 0; j < 16; ++j) v[j] = __builtin_nontemporal_load(xr + 64 * j);
#pragma unroll
                for (int j = 0; j < 16; ++j) sq[j >> 2] += (v[j].x * v[j].x + v[j].y * v[j].y) + (v[j].z * v[j].z + v[j].w * v[j].w);
#pragma unroll
                for (int q = 0; q < 4; ++q) sq[q] = wave_sum(sq[q]);
                if (lane == 0) { ss0[m] = sq[0]; ss0[m + 1] = sq[1]; ss0[m + 2] = sq[2]; ss0[m + 3] = sq[3]; }
                v2u* o8 = (v2u*)(XB + (size_t)m * DM) + lane;
#pragma unroll
                for (int j = 0; j < 16; ++j) o8[64 * j] = (v2u){pk2(v[j].x, v[j].y), pk2(v[j].z, v[j].w)}; }
            if (tid < 64) { ss1[rbase + tid] = 0.f; ss2[rbase + tid] = 0.f; ss3[rbase + tid] = 0.f; }
          } else {
            for (int m = gw; m < M; m += NGW) { const f32x4* xr = (const f32x4*)(x + (size_t)m * DM) + lane; f32x4 v[4]; float s0 = 0.f;
#pragma unroll
                for (int j = 0; j < 4; ++j) { v[j] = xr[64 * j]; s0 += (v[j].x * v[j].x + v[j].y * v[j].y) + (v[j].z * v[j].z + v[j].w * v[j].w); }
                s0 = wave_sum(s0); if (lane == 0) ss0[m] = s0;
                v2u* o8 = (v2u*)(XB + (size_t)m * DM) + lane;
#pragma unroll
                for (int j = 0; j < 4; ++j) o8[64 * j] = (v2u){pk2(v[j].x, v[j].y), pk2(v[j].z, v[j].w)}; }
            const int gt = vcu * 512 + tid, NGT = G * 512; const f32x4* pp = (const f32x4*)args.in[1]; v2u* po = (v2u*)PB;
            for (int i = gt; i < M * PLE / 4; i += NGT) { const f32x4 v = pp[i]; po[i] = (v2u){pk2(v.x, v.y), pk2(v.z, v.w)}; }
            for (int i = gt; i < 3 * M; i += NGT) ss1[i] = 0.f; } }
        __syncthreads();
    }
    SEAM(0);
    if (IN(1)) { pg8::Gemm g{XB, W1gu, M, 2 * FF, DM, DM, DM, 0, 0, 1}; pg8::StaticOrder S; S.init(M, 2 * FF, 1, G, bx);
        pg8::EpiSwiglu E{ss0, ACT}; pg8::gemm_phase<pg8::EpiSwiglu, true>(lds, g, S, E);
        if (bx >= 128) {
            OPAQUE_TID(); LAS float* scr = (LAS float*)(lds + wave * 16384);
            constexpr int J_D = (FF / 64) * (DM / 64), J_IN = (DM / 64) * (NIN / 64);
            for (int it = (bx - 128) * NWAVES + wave; it < J_D + J_IN; it += 128 * NWAVES) {
                if (it < J_D) p0_transpose_item(args.in[5], FF, DM, W1d, nullptr, 0, scr, it, lane);
                else p0_transpose_item(args.in[7], DM, NIN, Win, args.in[6], 3, scr, it - J_D, lane); }
            __syncthreads(); } }
    SEAM(1);
    if (IN(2)) { pg8::Gemm g{ACT, W1d, M, DM, FF, 64, FF, 0, 0, 1, (size_t)256 * 64 * 2, (size_t)(FF / 64) * 256 * 64 * 2}; pg8::StaticOrder S; S.init(M, DM, 1, G, bx);
        pg8::EpiResid<true> E{nullptr, XB, ss1, 0.5f}; pg8::gemm_phase<pg8::EpiResid<true>, true>(lds, g, S, E); }
    SEAM(2);
    if (IN(3)) { pg8::Gemm g{XB, Win, M, NIN, DM, DM, DM, 0, 0, 1}; pg8::StaticOrder S; S.init(M, NIN, 1, G, bx);
        pg8::EpiInProj E{ss1, QB_, KB, VB, AUG, (unsigned char*)GATES, args.in[8], args.in[9]}; pg8::gemm_phase<pg8::EpiInProj, true>(lds, g, S, E);
        if (bx >= 64 && bx < 192) { OPAQUE_TID(); s5_gen(lds, (bx - 64) >> 2, (bx - 64) & 3, tid, args.in[10], args.in[11], args.in[12], args.in[13], args.in[14], args.in[15], args.in[16], args.in[17], Wend, Wbig); }
        if (bx >= 192 && G == 256) {
            const int rb = 2048 * (bx & 7) + 256 * ((bx - 192) >> 3);
#pragma unroll 1
            for (int h = 0; h < 2; ++h) { const f32x4* pp = (const f32x4*)args.in[1] + (size_t)(rb + 128 * h) * (PLE / 4) + threadIdx.x; v2u* po = (v2u*)PB + (size_t)(rb + 128 * h) * (PLE / 4) + threadIdx.x; f32x4 v[16];
#pragma unroll
                for (int q = 0; q < 16; ++q) v[q] = __builtin_nontemporal_load(pp + 512 * q);
#pragma unroll
                for (int q = 0; q < 16; ++q) po[512 * q] = (v2u){pk2(v[q].x, v[q].y), pk2(v[q].z, v[q].w)}; } } }
    SEAM(3);
    if (IN(6)) {
        unsigned* scan_done = (unsigned*)(ws + WS_CTL) + 4096;
        if (bx < 64) {
            const int g = bx >> 1, b = bx & 1;
            { int one_ = 1, zero_ = 0, kq_ = 256; asm volatile("" : "+s"(one_), "+s"(zero_), "+s"(kq_)); pg8::Gemm gm{AUG + ((size_t)(g * 1024 + b * 512)) * 512, Wend + (size_t)g * 256 * 256, 512, 256, kq_, 512, 256, 0, 0, 1}; pg8::StaticOrder S; S.init(512, 256, 1, one_, zero_);
              pg8::EpiE E{EB + ((size_t)(g * 1024 + b * 512)) * 256}; pg8::gemm_phase<pg8::EpiE, true>(lds, gm, S, E); }
            __builtin_amdgcn_fence(__ATOMIC_ACQUIRE, "agent"); asm volatile("s_waitcnt vmcnt(0)" ::: "memory");
            OPAQUE_TID();
            const int p = lane, seg = wave;
#pragma unroll 1
            for (int dir = 0; dir < 2; ++dir) {
            const float lr = args.in[10][(dir * 32 + g) * 64 + p], li = args.in[11][(dir * 32 + g) * 64 + p], delta = expf(args.in[12][dir * 32 + g]);
            const float mag = expf(16.0f * delta * lr); float sn, cs; { const double rev = 16.0 * (double)delta * (double)li * 0.15915494309189535; sincos_rev((float)(rev - floor(rev)), sn, cs); }
            const float ar = mag * cs, ai = mag * sn;
            const float* Eb = EB + ((size_t)(g * 1024 + b * 512)) * 256 + dir * 128 + p;
            bf16* Ab = AUG + ((size_t)(g * 1024 + b * 512)) * 512 + 256 + dir * 128 + p;
            float er[64], ei[64];
#pragma unroll
            for (int q = 0; q < 64; ++q) { const int sidx = seg * 64 + q, c = dir ? 511 - sidx : sidx; er[q] = Eb[(size_t)c * 256]; ei[q] = Eb[(size_t)c * 256 + 64]; }
            float sr = 0.f, si = 0.f;
#pragma unroll
            for (int q = 0; q < 64; ++q) { const float nr = ar * sr - ai * si + er[q], ni = ar * si + ai * sr + ei[q]; sr = nr; si = ni; }
            LAS float* segE = (LAS float*)lds;
            segE[(seg * 64 + p) * 2] = sr; segE[(seg * 64 + p) * 2 + 1] = si;
            float br = ar, bi = ai;
#pragma unroll
            for (int q = 0; q < 6; ++q) { const float nr = br * br - bi * bi, ni = 2.0f * br * bi; br = nr; bi = ni; }
            __syncthreads();
            sr = 0.f; si = 0.f;
            for (int v = 0; v < seg; ++v) { const float e0 = segE[(v * 64 + p) * 2], e1 = segE[(v * 64 + p) * 2 + 1]; const float nr = br * sr - bi * si + e0, ni = br * si + bi * sr + e1; sr = nr; si = ni; }
            if (seg == 0) { bf16* z0 = Ab + (size_t)(dir ? 511 : 0) * 512; z0[0] = 0; z0[64] = 0; }
#pragma unroll
            for (int q = 0; q < 64; ++q) { const int sidx = seg * 64 + q, c = dir ? 511 - sidx : sidx; const float nr = ar * sr - ai * si + er[q], ni = ar * si + ai * sr + ei[q]; sr = nr; si = ni;
                const int cd = dir ? c - 1 : c + 1;
                if (cd >= 0 && cd < 512) { Ab[(size_t)cd * 512] = (bf16)f2bf(sr); Ab[(size_t)cd * 512 + 64] = (bf16)f2bf(si); } }
            __syncthreads();
            }
            asm volatile("s_waitcnt vmcnt(0) lgkmcnt(0)" ::: "memory"); __syncthreads();
            if (tid == 0) { __builtin_amdgcn_fence(__ATOMIC_RELEASE, "agent"); asm volatile("s_waitcnt vmcnt(0)" ::: "memory"); __hip_atomic_fetch_add(scan_done, 1u, __ATOMIC_RELAXED, __HIP_MEMORY_SCOPE_AGENT); }
        }
        float m2;
        { const int ln = threadIdx.x & 63; float gq = fabsf(args.in[8][ln]), gk = fabsf(args.in[9][ln]);
#pragma unroll
          for (int o = 1; o < 64; o <<= 1) { gq = fmaxf(gq, __shfl_xor(gq, o)); gk = fmaxf(gk, __shfl_xor(gk, o)); }
          m2 = 8.0f * gq * gk * 1.4426950408889634f * 1.002f; }
        for (int i = 0; i < 2; ++i) { const int u = vcu * 2 + i; if (u < 512) { const int bh = u >> 5, qb = u & 31;
            attn_body::attn_unit<8>(bh >> 3, bh & 7, qb, (const attn_body::bf16*)QB_, (const attn_body::bf16*)KB, (const attn_body::bf16*)VB, (attn_body::bf16*)QB_, (char*)lds_raw, m2); } }
        asm volatile("s_waitcnt vmcnt(0) lgkmcnt(0)" ::: "memory"); __syncthreads();
        if (bx >= 64 && bx < 128) {
            OPAQUE_TID(); LAS float* scr = (LAS float*)(lds + wave * 16384);
            constexpr int J_GU = (DM / 64) * (FF / 64), J_D = (FF / 64) * (DM / 64), J_GLU = (512 / 64) * (512 / 64), J_BR = (512 / 64) * (DM / 64), J_SQ = (DM / 64) * (DM / 64), J_PP = (PLE / 64) * (DM / 64);
            for (int it = (bx - 64) * NWAVES + wave; it < 2 * J_GU + J_D + J_GLU + 2 * J_BR + 2 * J_SQ + J_PP; it += 64 * NWAVES) { int r = it;
                if (r < J_GLU) { p0_transpose_item(args.in[18], 512, 512, Wglu, nullptr, 0, scr, r, lane); continue; } r -= J_GLU;
                if (r < J_BR) { p0_transpose_item(args.in[20], 512, DM, Wab, nullptr, 0, scr, r, lane); continue; } r -= J_BR;
                if (r < J_BR) { p0_transpose_item(args.in[21], 512, DM, Wsb, nullptr, 0, scr, r, lane); continue; } r -= J_BR;
                if (r < J_SQ) { p0_transpose_item(args.in[22], DM, DM, Wout, nullptr, 0, scr, r, lane); continue; } r -= J_SQ;
                if (r < J_GU) { p0_transpose_item(args.in[24], DM, FF, W2gu, args.in[23], 1, scr, r, lane); continue; } r -= J_GU;
                if (r < J_GU) { p0_transpose_item(args.in[25], DM, FF, W2gu, args.in[23], 2, scr, r, lane); continue; } r -= J_GU;
                if (r < J_D) { p0_transpose_item(args.in[26], FF, DM, W2d, nullptr, 0, scr, r, lane); continue; } r -= J_D;
                if (r < J_SQ) { p0_transpose_item(args.in[28], DM, DM, Wpg, args.in[27], 0, scr, r, lane); continue; } r -= J_SQ;
                p0_transpose_item(args.in[29], PLE, DM, Wpp, nullptr, 0, scr, r, lane); }
            __syncthreads(); }
        if (bx >= 128) {
            if (threadIdx.x == 0) { unsigned sp = 0; while (__hip_atomic_load(scan_done, __ATOMIC_RELAXED, __HIP_MEMORY_SCOPE_AGENT) < 64u && ++sp < (1u << 22)) __builtin_amdgcn_s_sleep(2);
                __builtin_amdgcn_fence(__ATOMIC_ACQUIRE, "agent"); asm volatile("s_waitcnt vmcnt(0)" ::: "memory"); }
            __syncthreads();
            pg8::Gemm g{AUG, Wbig, 1024, 256, 512, 512, 512, (size_t)1024 * 512, (size_t)256 * 512, 32}; pg8::StaticOrder S; S.init(1024, 256, 32, G - 128, bx - 128);
            pg8::EpiY E{ZB}; pg8::gemm_phase<pg8::EpiY, true>(lds, g, S, E); }
    }
    SEAM(6);
    if (IN(7)) { pg8::Gemm g{ZB, Wglu, M, 512, 512, 512, 512, 0, 0, 1}; pg8::StaticOrder S; S.init(M, 512, 1, G, bx);
        pg8::EpiGlu E{ZB, args.in[19], Z2B}; pg8::gemm_phase<pg8::EpiGlu, true>(lds, g, S, E); }
    SEAM(7);
    if (IN(8)) { pg8::StaticOrder S; S.init(M, DM, 1, G, bx);
        { pg8::Gemm g{QB_, Wab, M, DM, 512, 512, 512, 0, 0, 1}; pg8::EpiBranch<false> E{(const unsigned char*)GATES, 0, MG}; pg8::gemm_phase<pg8::EpiBranch<false>, true>(lds, g, S, E); }
        { pg8::Gemm g{Z2B, Wsb, M, DM, 512, 512, 512, 0, 0, 1}; pg8::EpiBranch<true> E{(const unsigned char*)GATES, 1024, MG}; pg8::gemm_phase<pg8::EpiBranch<true>, true>(lds, g, S, E); } }
    SEAM(8);
    if (IN(9)) { pg8::Gemm g{MG, Wout, M, DM, DM, DM, DM, 0, 0, 1}; pg8::StaticOrder S; S.init(M, DM, 1, G, bx);
        pg8::EpiResid<true> E{nullptr, XB, ss2, 1.0f}; pg8::gemm_phase<pg8::EpiResid<true>, true>(lds, g, S, E); }
    SEAM(9);
    if (IN(10)) { pg8::Gemm g{XB, W2gu, M, 2 * FF, DM, DM, DM, 0, 0, 1}; pg8::StaticOrder S; S.init(M, 2 * FF, 1, G, bx);
        pg8::EpiSwiglu E{ss2, ACT}; pg8::gemm_phase<pg8::EpiSwiglu, true>(lds, g, S, E);
        if (bx >= 128) {
            pg8::Gemm g2{PB, Wpp, M, DM, PLE, PLE, PLE, 0, 0, 1}; pg8::StaticOrder S2; S2.init(M, DM, 1, G - 128, bx - 128);
            pg8::EpiPle1 E2{PTMP}; pg8::gemm_phase<pg8::EpiPle1, true>(lds, g2, S2, E2); } }
    SEAM(10);
    if (IN(11)) { pg8::Gemm g{ACT, W2d, M, DM, FF, 64, FF, 0, 0, 1, (size_t)256 * 64 * 2, (size_t)(FF / 64) * 256 * 64 * 2}; pg8::StaticOrder S; S.init(M, DM, 1, G, bx);
        pg8::EpiResid<true> E{nullptr, XB, ss3, 0.5f}; pg8::gemm_phase<pg8::EpiResid<true>, true>(lds, g, S, E); }
    SEAM(11);
    if (IN(12)) { pg8::StaticOrder S; S.init(M, DM, 1, G, bx);
        { pg8::Gemm g{XB, Wpg, M, DM, DM, DM, DM, 0, 0, 1}; pg8::EpiPle2 E{ss3, PTMP, XB, out}; pg8::gemm_phase<pg8::EpiPle2, true>(lds, g, S, E); } }
#undef IN
#undef SEAM
}

#ifndef MK_N_LAUNCHES
#define MK_N_LAUNCHES 1
#endif
extern "C" void kernel_launch(void* const* d_in, const int* in_sizes, int n_in, void* d_out, int out_size, void* d_ws, size_t ws_size, hipStream_t stream) {
    static int grid = 0;
    if (grid == 0) {
        if (n_in != 30 || out_size != M * DM || ws_size < WS_END) { fprintf(stderr, "kernel_launch: unexpected shapes (n_in %d out %d ws %zu)\n", n_in, out_size, ws_size); grid = -1; return; }
        int dev = 0, cus = 0, per_cu = 0;
        hipGetDevice(&dev); hipDeviceGetAttribute(&cus, hipDeviceAttributeMultiprocessorCount, dev);
        if (hipFuncSetAttribute((const void*)mega_fwd, hipFuncAttributeMaxDynamicSharedMemorySize, LDS_BYTES) != hipSuccess) { fprintf(stderr, "kernel_launch: hipFuncSetAttribute failed\n"); grid = -1; return; }
        if (hipOccupancyMaxActiveBlocksPerMultiprocessor(&per_cu, (const void*)mega_fwd, NWAVES * 64, LDS_BYTES) != hipSuccess || per_cu < 1) { fprintf(stderr, "kernel_launch: occupancy query says %d\n", per_cu); per_cu = 1; }
        (void)hipGetLastError();
        grid = cus;
        fprintf(stderr, "kernel_launch: grid %d (cus %d, per_cu %d)\n", grid, cus, per_cu);
    }
    if (grid < 0) return;
    if (hipMemsetAsync((char*)d_ws + WS_CTL, 0, CTL_BYTES, stream) != hipSuccess) { fprintf(stderr, "kernel_launch: memset failed\n"); return; }
    Args a{};
    for (int i = 0; i < 30; ++i) a.in[i] = (const float*)d_in[i];
    a.out = (float*)d_out; a.ws = (unsigned char*)d_ws;
#if MK_N_LAUNCHES == 1
    a.ph_lo = 0; a.ph_hi = N_PHASES;
    void* params[] = {&a};
    hipError_t e = hipLaunchCooperativeKernel((const void*)mega_fwd, dim3(grid), dim3(NWAVES * 64), params, LDS_BYTES, stream);
    if (e != hipSuccess) fprintf(stderr, "kernel_launch: cooperative launch failed: %s\n", hipGetErrorString(e));
#else
    for (int ph = 0; ph < N_PHASES; ++ph) { a.ph_lo = ph; a.ph_hi = ph + 1;
        hipLaunchKernelGGL(mega_fwd, dim3(grid), dim3(NWAVES * 64), LDS_BYTES, stream, a); }
#endif
}
```

```cpp
#include <hip/hip_runtime.h>
#include <hip/hip_cooperative_groups.h>
#include <hip/hip_bf16.h>
#include <cstdio>
#include <cstdint>
#include <cmath>
namespace cg = cooperative_groups;

#define LAS __attribute__((address_space(3)))
#define GAS __attribute__((address_space(1)))

constexpr int M = 16384, DM = 1024, FF = 2816, NIN = 3328, SEQ = 8192, PLE = 256;
constexpr float NORM_EPS = 1e-6f;
constexpr float C2 = 0.125f * 1.4426950408889634f;

namespace pg8 {
typedef unsigned short bf16_t;
typedef short bf16x8 __attribute__((ext_vector_type(8)));
typedef float f32x4 __attribute__((ext_vector_type(4)));
typedef unsigned u32x4 __attribute__((ext_vector_type(4)));
typedef unsigned u32x2 __attribute__((ext_vector_type(2)));
constexpr int BM = 256, BK = 64, HALF = 128, HTB = HALF * BK * 2, STAGE_BYTES = 8 * HTB, NXCD = 8, WGM = 8;

__host__ __device__ __forceinline__ int lds_byte(int r, int c) { const int st = (r >> 4) * 2 + (c >> 5), rr = r & 15, cc = c & 31, ob = rr * 64 + cc * 2; return st * 1024 + (ob ^ (((ob >> 9) & 1) << 5)); }
__host__ __device__ __forceinline__ void stage_rc(int b, int& R, int& C) { const int st = b / 1024, sb = b % 1024, swz = sb ^ (((sb >> 9) & 1) << 5); R = (st >> 1) * 16 + swz / 64; C = (st & 1) * 32 + (swz % 64) / 2; }
__host__ __device__ __forceinline__ int perm32(int rho) { const int n = rho >> 4, i = rho & 15; return 8 * (i >> 2) + 4 * n + (i & 3); }

struct Unit { int pm, pn, pb; };
struct Gemm { const bf16_t* A; const bf16_t* Bt; int M, N, K, lda, ldb; size_t sA, sB; int nb; size_t ksA = 0, tsA_ = 0; };

struct StaticOrder {
    int nM, nN, per, nwg, G, c;
    __device__ void init(int M_, int N_, int nb, int G_, int c_) { nM = M_ / BM; nN = N_ / BM; per = nM * nN; nwg = per * nb; G = G_; c = c_; }
    __device__ bool next(int i, Unit& u) const {
        const long L = (long)i * G + c; if (L >= nwg) return false;
        int wgid = (int)L; { const int q = nwg / NXCD, r = nwg % NXCD, xcd = wgid % NXCD, off = wgid / NXCD; wgid = (xcd < r ? xcd * (q + 1) : r * (q + 1) + (xcd - r) * q) + off; }
        u.pb = wgid / per; wgid -= u.pb * per;
        const int nig = WGM * nN, gid = wgid / nig, fm = gid * WGM, gsz = (nM - fm) < WGM ? (nM - fm) : WGM;
        u.pm = fm + ((wgid % nig) % gsz); u.pn = (wgid % nig) / gsz; return true;
    }
};

__device__ __forceinline__ unsigned cvt_pk_bf16(float lo, float hi) { unsigned r; asm volatile("v_cvt_pk_bf16_f32 %0, %1, %2" : "=v"(r) : "v"(lo), "v"(hi)); return r; }
__device__ __forceinline__ float bf_lo(unsigned w) { return __uint_as_float(w << 16); }
__device__ __forceinline__ float bf_hi(unsigned w) { return __uint_as_float(w & 0xffff0000u); }
__device__ __forceinline__ float sigm(float x) { return __builtin_amdgcn_rcpf(1.0f + __builtin_amdgcn_exp2f(-1.4426950408889634f * x)); }
__device__ __forceinline__ unsigned q8(const f32x4& v) { return (unsigned)(v[0] * 255.0f + 0.5f) | ((unsigned)(v[1] * 255.0f + 0.5f) << 8) | ((unsigned)(v[2] * 255.0f + 0.5f) << 16) | ((unsigned)(v[3] * 255.0f + 0.5f) << 24); }
__device__ __forceinline__ f32x4 dq8(unsigned w) { return (f32x4){(float)(w & 255u), (float)((w >> 8) & 255u), (float)((w >> 16) & 255u), (float)(w >> 24)} * (1.0f / 255.0f); }
__device__ __forceinline__ f32x4 sigm4(const f32x4& x, float k) { f32x4 d = x * (-1.4426950408889634f * k);
#pragma unroll
    for (int e = 0; e < 4; ++e) d[e] = __builtin_amdgcn_exp2f(d[e]);
    d = d + 1.0f;
#pragma unroll
    for (int e = 0; e < 4; ++e) d[e] = __builtin_amdgcn_rcpf(d[e]);
    return d; }
__device__ __forceinline__ unsigned q8s(const f32x4& s) { const f32x4 v = s * 255.0f + 0.5f; return (unsigned)v[0] | ((unsigned)v[1] << 8) | ((unsigned)v[2] << 16) | ((unsigned)v[3] << 24); }
__device__ __forceinline__ float gelu_tanh(float x) { return x * sigm(1.5957691216057308f * (x + 0.044715f * x * x * x)); }
__device__ __forceinline__ u32x4 pack8(const f32x4& a, const f32x4& b) { u32x4 w; w.x = cvt_pk_bf16(a[0], a[1]); w.y = cvt_pk_bf16(a[2], a[3]); w.z = cvt_pk_bf16(b[0], b[1]); w.w = cvt_pk_bf16(b[2], b[3]); return w; }
__device__ __forceinline__ void unpack8(const u32x4& w, f32x4& a, f32x4& b) { a = (f32x4){bf_lo(w.x), bf_hi(w.x), bf_lo(w.y), bf_hi(w.y)}; b = (f32x4){bf_lo(w.z), bf_hi(w.z), bf_lo(w.w), bf_hi(w.w)}; }
__device__ __forceinline__ float rs_of(const float* ss, int row) { return __builtin_amdgcn_rsqf(ss[row] * (1.0f / 1024.0f) + NORM_EPS); }

#define EPI_ROWS  _Pragma("unroll") for (int ai = 0; ai < 2; ++ai) _Pragma("unroll") for (int m = 0; m < 4; ++m)
typedef const f32x4 (&AccRef)[2][2][4][2];

struct EpiSwiglu {
    static constexpr bool PERM = true;
    const float* ss; bf16_t* act;
    __device__ __forceinline__ void operator()(AccRef acc, const Unit& u, int wr, int wc, int fr, int fq) const {
        const int row0 = u.pm * BM + wr * 64 + fr, col0 = u.pn * 128 + wc * 32 + 8 * fq;
        float rr[2][4];
        EPI_ROWS rr[ai][m] = ss[row0 + ai * HALF + m * 16];
        EPI_ROWS { const int row = row0 + ai * HALF + m * 16; const float r = __builtin_amdgcn_rsqf(rr[ai][m] * (1.0f / 1024.0f) + NORM_EPS);
            f32x4 o[2], d[2]; const float c = -1.4426950408889634f * r, r2 = r * r;
#pragma unroll
            for (int n = 0; n < 2; ++n) { d[n] = acc[ai][0][m][n] * c; o[n] = (acc[ai][0][m][n] * acc[ai][1][m][n]) * r2; }
#pragma unroll
            for (int n = 0; n < 2; ++n)
#pragma unroll
                for (int e = 0; e < 4; ++e) d[n][e] = __builtin_amdgcn_exp2f(d[n][e]);
            d[0] = d[0] + 1.0f; d[1] = d[1] + 1.0f;
#pragma unroll
            for (int n = 0; n < 2; ++n)
#pragma unroll
                for (int e = 0; e < 4; ++e) d[n][e] = __builtin_amdgcn_rcpf(d[n][e]);
            o[0] = o[0] * d[0]; o[1] = o[1] * d[1];
            *(u32x4*)(act + (((size_t)(row >> 8) * (FF / 64) + (col0 >> 6)) * 256 + (row & 255)) * 64 + (col0 & 63)) = pack8(o[0], o[1]); }
    }
};
template <bool BF> struct EpiResid {
    static constexpr bool PERM = true;
    const float* base; bf16_t* xb; float* ssn; float scale;
    __device__ __forceinline__ void operator()(AccRef acc, const Unit& u, int wr, int wc, int fr, int fq) const {
        const int row0 = u.pm * BM + wr * 64 + fr, col0 = u.pn * BM + wc * 32 + 8 * fq;
#pragma unroll
        for (int ai = 0; ai < 2; ++ai) { f32x4 bv[4][2][2]; u32x4 bw[4][2];
#pragma unroll
            for (int m = 0; m < 4; ++m)
#pragma unroll
                for (int bj = 0; bj < 2; ++bj) { const size_t off = (size_t)(row0 + ai * HALF + m * 16) * DM + col0 + bj * HALF;
                    if (BF) bw[m][bj] = *(const u32x4*)(xb + off); else { bv[m][bj][0] = *(const f32x4*)(base + off); bv[m][bj][1] = *(const f32x4*)(base + off + 4); } }
            asm volatile("" ::: "memory");
#pragma unroll
            for (int m = 0; m < 4; ++m) { const int row = row0 + ai * HALF + m * 16; float s = 0.f;
#pragma unroll
                for (int bj = 0; bj < 2; ++bj) { const size_t off = (size_t)row * DM + col0 + bj * HALF;
                    f32x4 b0, b1; if (BF) unpack8(bw[m][bj], b0, b1); else { b0 = bv[m][bj][0]; b1 = bv[m][bj][1]; }
                    const f32x4 h0 = b0 + acc[ai][bj][m][0] * scale, h1 = b1 + acc[ai][bj][m][1] * scale;
                    *(u32x4*)(xb + off) = pack8(h0, h1);
                    s += (h0[0] * h0[0] + h0[1] * h0[1]) + (h0[2] * h0[2] + h0[3] * h0[3]) + (h1[0] * h1[0] + h1[1] * h1[1]) + (h1[2] * h1[2] + h1[3] * h1[3]); }
                s += __shfl_xor(s, 16); s += __shfl_xor(s, 32);
                if (fq == 0) atomicAdd(ssn + row, s); }
            asm volatile("" ::: "memory"); }
    }
};
struct EpiInProj {
    static constexpr bool PERM = true;
    const float* ss; bf16_t* q; bf16_t* k; bf16_t* v; bf16_t* aug; unsigned char* gates; const float* qg; const float* kg;
    __device__ __forceinline__ void operator()(AccRef acc, const Unit& u, int wr, int wc, int fr, int fq) const {
        const int row0 = u.pm * BM + wr * 64 + fr, cw = wc * 32 + 8 * fq, pn = u.pn;
        float rr[2][4];
        EPI_ROWS rr[ai][m] = ss[row0 + ai * HALF + m * 16];
        if (pn < 2 || (pn == 2 && wc < 2)) {
            const float* gn = pn < 2 ? qg : kg; const float sc = pn < 2 ? C2 : 1.0f;
            float g1[8], g2[8], fr8[8];
#pragma unroll
            for (int j = 0; j < 8; ++j) { g1[j] = gn[8 * fq + j] * sc; g2[j] = gn[32 + 8 * fq + j] * sc;
                fr8[j] = __builtin_amdgcn_exp2f(-(float)(8 * (fq & 1) + j) * (13.287712379549449f / 16.0f)) * 0.15915494309189535f; }
            bf16_t* base = pn < 2 ? q + (pn * 4 + wc) * 64 : k + wc * 64; const int pitch = pn < 2 ? 512 : 128;
            EPI_ROWS { const int row = row0 + ai * HALF + m * 16; const float r = __builtin_amdgcn_rsqf(rr[ai][m] * (1.0f / 1024.0f) + NORM_EPS); const int t = row & (SEQ - 1); const float pos = (float)(fq < 2 ? (t >> 6) : (t & 63));
                float x1[8], x2[8]; float s2 = 0.f;
#pragma unroll
                for (int j = 0; j < 8; ++j) { x1[j] = acc[ai][0][m][j >> 2][j & 3] * r; x2[j] = acc[ai][1][m][j >> 2][j & 3] * r; s2 += x1[j] * x1[j] + x2[j] * x2[j]; }
                s2 += __shfl_xor(s2, 16); s2 += __shfl_xor(s2, 32);
                const float rn = __builtin_amdgcn_rsqf(s2 * (1.0f / 64.0f) + NORM_EPS);
                f32x4 o1[2], o2[2];
#pragma unroll
                for (int j = 0; j < 8; ++j) { const float rev = pos * fr8[j], f = rev - __builtin_floorf(rev), sn = __builtin_amdgcn_sinf(f), cs = __builtin_amdgcn_cosf(f);
                    const float y1 = x1[j] * rn * g1[j], y2 = x2[j] * rn * g2[j]; o1[j >> 2][j & 3] = y1 * cs - y2 * sn; o2[j >> 2][j & 3] = y2 * cs + y1 * sn; }
                bf16_t* d = base + (size_t)row * pitch + 8 * fq;
                *(u32x4*)d = pack8(o1[0], o1[1]); *(u32x4*)(d + 32) = pack8(o2[0], o2[1]); }
            return; }
        EPI_ROWS { const int row = row0 + ai * HALF + m * 16; const float r = __builtin_amdgcn_rsqf(rr[ai][m] * (1.0f / 1024.0f) + NORM_EPS);
#pragma unroll
            for (int bj = 0; bj < 2; ++bj) { f32x4 v0 = acc[ai][bj][m][0] * r, v1 = acc[ai][bj][m][1] * r; bf16_t* dst;
                if (pn >= 5) { const f32x4 s0 = sigm4(acc[ai][bj][m][0], r), s1 = sigm4(acc[ai][bj][m][1], r);
                    *(u32x2*)(gates + (size_t)row * 2048 + (pn - 5) * 256 + bj * HALF + cw) = (u32x2){q8s(s0), q8s(s1)}; continue; }
                if (pn == 2) dst = v + (size_t)row * 128 + 64 * (wc - 2) + 32 * bj + 8 * fq;
                else { const int cs = (pn - 3) * 256 + bj * HALF + cw, g = cs >> 4, h0 = cs & 15, b = row >> 13, t = row & 8191, c = t >> 4, tl = t & 15;
                    dst = aug + ((size_t)(g * 1024 + b * 512 + c)) * 512 + tl * 16 + h0; }
                *(u32x4*)dst = pack8(v0, v1); } }
    }
};
struct EpiE {
    static constexpr bool PERM = true;
    float* E;
    __device__ __forceinline__ void operator()(AccRef acc, const Unit& u, int wr, int wc, int fr, int fq) const {
        const int row0 = u.pm * BM + wr * 64 + fr, cw = wc * 32 + 8 * fq;
        EPI_ROWS { const int row = row0 + ai * HALF + m * 16;
#pragma unroll
            for (int bj = 0; bj < 2; ++bj) { float* d = E + ((size_t)(u.pb * 1024 + row)) * 256 + bj * HALF + cw; *(f32x4*)d = acc[ai][bj][m][0]; *(f32x4*)(d + 4) = acc[ai][bj][m][1]; } }
    }
};
struct EpiY {
    static constexpr bool PERM = true;
    bf16_t* z;
    __device__ __forceinline__ void operator()(AccRef acc, const Unit& u, int wr, int wc, int fr, int fq) const {
        const int row0 = u.pm * BM + wr * 64 + fr, cw = wc * 32 + 8 * fq;
        EPI_ROWS { const int row = row0 + ai * HALF + m * 16, b = row >> 9, c = row & 511;
#pragma unroll
            for (int bj = 0; bj < 2; ++bj) { const int nn = bj * HALF + cw, tl = nn >> 4, h0 = nn & 15; f32x4 v0 = acc[ai][bj][m][0], v1 = acc[ai][bj][m][1];
#pragma unroll
                for (int e = 0; e < 1; ++e) { v0 = v0 * sigm4(v0 * (v0 * v0 * 0.044715f + 1.0f), 1.5957691216057308f); v1 = v1 * sigm4(v1 * (v1 * v1 * 0.044715f + 1.0f), 1.5957691216057308f); }
                *(u32x4*)(z + ((size_t)(b * SEQ + c * 16 + tl)) * 512 + u.pb * 16 + h0) = pack8(v0, v1); } }
    }
};
struct EpiGlu {
    static constexpr bool PERM = true;
    const bf16_t* z; const float* bias; bf16_t* z2;
    __device__ __forceinline__ void operator()(AccRef acc, const Unit& u, int wr, int wc, int fr, int fq) const {
        const int row0 = u.pm * BM + wr * 64 + fr, col0 = u.pn * BM + wc * 32 + 8 * fq;
        u32x4 zv[2][4][2]; f32x4 bb[2][2];
        EPI_ROWS
#pragma unroll
            for (int bj = 0; bj < 2; ++bj) zv[ai][m][bj] = *(const u32x4*)(z + (size_t)(row0 + ai * HALF + m * 16) * 512 + col0 + bj * HALF);
#pragma unroll
        for (int bj = 0; bj < 2; ++bj) { bb[bj][0] = *(const f32x4*)(bias + col0 + bj * HALF); bb[bj][1] = *(const f32x4*)(bias + col0 + bj * HALF + 4); }
        asm volatile("" ::: "memory");
        EPI_ROWS { const int row = row0 + ai * HALF + m * 16;
#pragma unroll
            for (int bj = 0; bj < 2; ++bj) { const size_t off = (size_t)row * 512 + col0 + bj * HALF; f32x4 z0, z1; unpack8(zv[ai][m][bj], z0, z1);
                const f32x4 v0 = z0 * sigm4(acc[ai][bj][m][0] + bb[bj][0], 1.0f), v1 = z1 * sigm4(acc[ai][bj][m][1] + bb[bj][1], 1.0f);
                *(u32x4*)(z2 + off) = pack8(v0, v1); } }
    }
};
template <bool ADD> struct EpiBranch {
    static constexpr bool PERM = true;
    const unsigned char* gates; int goff; bf16_t* mg;
    __device__ __forceinline__ void operator()(AccRef acc, const Unit& u, int wr, int wc, int fr, int fq) const {
        const int row0 = u.pm * BM + wr * 64 + fr, col0 = u.pn * BM + wc * 32 + 8 * fq;
#pragma unroll
        for (int ai = 0; ai < 2; ++ai) { u32x2 gv[4][2]; u32x4 pv[4][2];
#pragma unroll
            for (int m = 0; m < 4; ++m)
#pragma unroll
                for (int bj = 0; bj < 2; ++bj) { const int row = row0 + ai * HALF + m * 16, col = col0 + bj * HALF; gv[m][bj] = *(const u32x2*)(gates + (size_t)row * 2048 + goff + col);
                    if (ADD) pv[m][bj] = *(const u32x4*)(mg + (size_t)row * DM + col); }
            asm volatile("" ::: "memory");
#pragma unroll
            for (int m = 0; m < 4; ++m) { const int row = row0 + ai * HALF + m * 16;
#pragma unroll
                for (int bj = 0; bj < 2; ++bj) { const int col = col0 + bj * HALF; const f32x4 g0 = dq8(gv[m][bj].x), g1 = dq8(gv[m][bj].y);
                    f32x4 v0 = acc[ai][bj][m][0] * g0, v1 = acc[ai][bj][m][1] * g1;
                    if (ADD) { f32x4 p0, p1; unpack8(pv[m][bj], p0, p1); v0 += p0; v1 += p1; }
                    *(u32x4*)(mg + (size_t)row * DM + col) = pack8(v0, v1); } }
            asm volatile("" ::: "memory"); }
    }
};
struct EpiPle1 {
    static constexpr bool PERM = true;
    bf16_t* tmp;
    __device__ __forceinline__ void operator()(AccRef acc, const Unit& u, int wr, int wc, int fr, int fq) const {
        const int row0 = u.pm * BM + wr * 64 + fr, col0 = u.pn * BM + wc * 32 + 8 * fq;
        EPI_ROWS { const int row = row0 + ai * HALF + m * 16;
#pragma unroll
            for (int bj = 0; bj < 2; ++bj) *(u32x4*)(tmp + (size_t)row * DM + col0 + bj * HALF) = pack8(acc[ai][bj][m][0], acc[ai][bj][m][1]); }
    }
};
struct EpiPle2 {
    static constexpr bool PERM = true;
    const float* ss; const bf16_t* tmp; const bf16_t* hb; float* out;
    __device__ __forceinline__ void operator()(AccRef acc, const Unit& u, int wr, int wc, int fr, int fq) const {
        const int row0 = u.pm * BM + wr * 64 + fr, col0 = u.pn * BM + wc * 32 + 8 * fq;
        float rr[2][4];
        EPI_ROWS rr[ai][m] = ss[row0 + ai * HALF + m * 16];
#pragma unroll
        for (int ai = 0; ai < 2; ++ai) { u32x4 tv[4][2], hv[4][2];
#pragma unroll
            for (int m = 0; m < 4; ++m)
#pragma unroll
                for (int bj = 0; bj < 2; ++bj) { const size_t off = (size_t)(row0 + ai * HALF + m * 16) * DM + col0 + bj * HALF; tv[m][bj] = *(const u32x4*)(tmp + off); hv[m][bj] = *(const u32x4*)(hb + off); }
            asm volatile("" ::: "memory");
#pragma unroll
            for (int m = 0; m < 4; ++m) { const float r = __builtin_amdgcn_rsqf(rr[ai][m] * (1.0f / 1024.0f) + NORM_EPS);
#pragma unroll
                for (int bj = 0; bj < 2; ++bj) { const size_t off = (size_t)(row0 + ai * HALF + m * 16) * DM + col0 + bj * HALF; f32x4 t0, t1, h0, h1; unpack8(tv[m][bj], t0, t1); unpack8(hv[m][bj], h0, h1);
                    const f32x4 o0 = h0 + sigm4(acc[ai][bj][m][0], r) * t0, o1 = h1 + sigm4(acc[ai][bj][m][1], r) * t1;
                    *(f32x4*)(out + off) = o0; *(f32x4*)(out + off + 4) = o1; } } }
    }
};

template <class Epi, bool ALIGN_EPI>
__device__ __forceinline__ void gemm_phase(LAS unsigned char* lds, const Gemm g, const StaticOrder& S, const Epi& E) {
    int tid_o = threadIdx.x; asm volatile("" : "+v"(tid_o));
    const int tid = tid_o, wid = __builtin_amdgcn_readfirstlane(tid >> 6), lane = tid & 63, wr = wid >> 2, wc = wid & 3, fr = lane & 15, fq = lane >> 4;
    const int K = g.K, nt = K / BK;
    unsigned voffA[2], voffB[2];
#pragma unroll
    for (int i = 0; i < 2; ++i) { int R, C; stage_rc(tid * 16 + i * 8192, R, C); const int Rb = Epi::PERM ? ((R & ~31) + perm32(R & 31)) : R;
        voffA[i] = (unsigned)(R * g.lda + C) * 2u; voffB[i] = (unsigned)(Rb * g.ldb + C) * 2u; }
    const size_t kstep = (size_t)(BK * 2), kstepA = g.ksA ? g.ksA : kstep;
    const size_t hsA = (size_t)HALF * g.lda * 2, hsB = (size_t)HALF * g.ldb * 2;
    const size_t tsA = g.tsA_ ? g.tsA_ : 2 * hsA, tsB = 2 * hsB;
    const unsigned ldsw = (unsigned)wid * 1024u;
    const int aoff = lds_byte(wr * 64 + fr, fq * 8), boff = lds_byte(wc * 32 + fr, fq * 8);
#define PG8_SA(b, h) (((b) * 2 + (h)) * HTB)
#define PG8_SB(b, h) ((4 + (b) * 2 + (h)) * HTB)
#define PG8_STAGE(bufoff, gbase, voff) do { _Pragma("unroll") for (int _i = 0; _i < 2; ++_i) \
        __builtin_amdgcn_global_load_lds((const unsigned*)((const char*)(gbase) + (voff)[_i]), (LAS unsigned*)(lds + (bufoff) + ldsw + _i * 8192), 16, 0, 0); } while (0)
#define PG8_LDA(dst, b, h) do { _Pragma("unroll") for (int m = 0; m < 4; ++m) _Pragma("unroll") for (int k = 0; k < 2; ++k) dst[m][k] = *(const LAS bf16x8*)(lds + PG8_SA(b, h) + aoff + m * 2048 + k * 1024); } while (0)
#define PG8_LDB(dst, b, h) do { _Pragma("unroll") for (int n = 0; n < 2; ++n) _Pragma("unroll") for (int k = 0; k < 2; ++k) dst[n][k] = *(const LAS bf16x8*)(lds + PG8_SB(b, h) + boff + n * 2048 + k * 1024); } while (0)
#define PG8_MMA(ai, bj, At, Bt) do { __builtin_amdgcn_s_setprio(1); _Pragma("unroll") for (int m = 0; m < 4; ++m) _Pragma("unroll") for (int n = 0; n < 2; ++n) _Pragma("unroll") for (int k = 0; k < 2; ++k) \
        acc[ai][bj][m][n] = __builtin_amdgcn_mfma_f32_16x16x32_bf16(Bt[n][k], At[m][k], acc[ai][bj][m][n], 0, 0, 0); __builtin_amdgcn_s_setprio(0); } while (0)
#define PG8_WAIT_V(n) asm volatile("s_waitcnt vmcnt(" #n ")" ::: "memory")
#define PG8_WAIT_L(n) asm volatile("s_waitcnt lgkmcnt(" #n ")" ::: "memory")
#define PG8_BAR __builtin_amdgcn_s_barrier()
#define PG8_SCHED __builtin_amdgcn_sched_barrier(0)
    Unit cur, nxt; int ui = 0;
    if (!S.next(0, cur)) return;
    f32x4 acc[2][2][4][2];
#pragma unroll
    for (int a = 0; a < 2; ++a)
#pragma unroll
        for (int b = 0; b < 2; ++b)
#pragma unroll
            for (int m = 0; m < 4; ++m)
#pragma unroll
                for (int n = 0; n < 2; ++n) acc[a][b][m][n] = (f32x4){0.f, 0.f, 0.f, 0.f};
    bf16x8 At[4][2], B0[2][2], B1[2][2];
    const char* cA = (const char*)g.A + (size_t)cur.pb * g.sA * 2 + (size_t)cur.pm * tsA; const char* cB = (const char*)g.Bt + (size_t)cur.pb * g.sB * 2 + (size_t)cur.pn * tsB;
    PG8_STAGE(PG8_SB(0, 0), cB, voffB); PG8_STAGE(PG8_SB(0, 1), cB + hsB, voffB); PG8_STAGE(PG8_SA(0, 0), cA, voffA); PG8_STAGE(PG8_SA(0, 1), cA + hsA, voffA);
    if (wr == 1) PG8_BAR;
    PG8_WAIT_V(2); PG8_BAR;
    PG8_STAGE(PG8_SB(1, 0), cB + kstep, voffB); PG8_STAGE(PG8_SA(1, 0), cA + kstepA, voffA); PG8_STAGE(PG8_SB(1, 1), cB + hsB + kstep, voffB);
    PG8_WAIT_V(6); PG8_BAR;
    for (;;) {
        const bool has_next = S.next(ui + 1, nxt);
        const char* nA = has_next ? (const char*)g.A + (size_t)nxt.pb * g.sA * 2 + (size_t)nxt.pm * tsA : cA; const char* nB = has_next ? (const char*)g.Bt + (size_t)nxt.pb * g.sB * 2 + (size_t)nxt.pn * tsB : cB;
        for (int t = 0; t < nt; t += 2) {
            const bool last = (t == nt - 2);
            const char* a1 = cA + (size_t)(t + 1) * kstepA;
            const char* a2 = last ? nA : cA + (size_t)(t + 2) * kstepA; const char* b2 = last ? nB : cB + (size_t)(t + 2) * kstep;
            const char* a3 = a2 + kstepA; const char* b3 = b2 + kstep;
            PG8_LDB(B0, 0, 0); PG8_LDB(B1, 0, 1); PG8_SCHED; PG8_LDA(At, 0, 0); PG8_STAGE(PG8_SA(1, 1), a1 + hsA, voffA);
            PG8_WAIT_V(8); PG8_WAIT_L(0); PG8_BAR; PG8_MMA(0, 0, At, B0); PG8_MMA(0, 1, At, B1); PG8_BAR; PG8_SCHED;
            PG8_LDA(At, 0, 1); PG8_STAGE(PG8_SB(0, 0), b2, voffB); PG8_STAGE(PG8_SB(0, 1), b2 + hsB, voffB); PG8_STAGE(PG8_SA(0, 0), a2, voffA);
            PG8_WAIT_V(8); PG8_WAIT_L(0); PG8_BAR; PG8_MMA(1, 0, At, B0); PG8_MMA(1, 1, At, B1); PG8_BAR; PG8_SCHED;
            PG8_LDB(B0, 1, 0); PG8_LDB(B1, 1, 1); PG8_SCHED; PG8_LDA(At, 1, 0); PG8_STAGE(PG8_SA(0, 1), a2 + hsA, voffA);
            PG8_WAIT_V(8); PG8_WAIT_L(0); PG8_BAR; PG8_MMA(0, 0, At, B0); PG8_MMA(0, 1, At, B1); PG8_BAR; PG8_SCHED;
            PG8_LDA(At, 1, 1); PG8_STAGE(PG8_SB(1, 0), b3, voffB); PG8_STAGE(PG8_SB(1, 1), b3 + hsB, voffB); PG8_STAGE(PG8_SA(1, 0), a3, voffA);
            PG8_WAIT_V(8); PG8_WAIT_L(0); PG8_BAR; PG8_MMA(1, 0, At, B0); PG8_MMA(1, 1, At, B1); PG8_BAR; PG8_SCHED;
        }
        if constexpr (ALIGN_EPI) { if (wr == 0) PG8_BAR; }
        E(acc, cur, wr, wc, fr, fq);
        if (!has_next) break;
#pragma unroll
        for (int a = 0; a < 2; ++a)
#pragma unroll
            for (int b = 0; b < 2; ++b)
#pragma unroll
                for (int m = 0; m < 4; ++m)
#pragma unroll
                    for (int n = 0; n < 2; ++n) acc[a][b][m][n] = (f32x4){0.f, 0.f, 0.f, 0.f};
        cur = nxt; cA = nA; cB = nB; ++ui;
        if constexpr (ALIGN_EPI) { if (wr == 1) PG8_BAR; }
    }
    PG8_WAIT_V(0);
    if constexpr (!ALIGN_EPI) { if (wr == 0) PG8_BAR; }
    PG8_BAR;
#undef PG8_SA
#undef PG8_SB
#undef PG8_STAGE
#undef PG8_LDA
#undef PG8_LDB
#undef PG8_MMA
#undef PG8_WAIT_V
#undef PG8_WAIT_L
#undef PG8_BAR
#undef PG8_SCHED
}
}

namespace attn_body {
using bf16=__hip_bfloat16;
using bf16x8=__attribute__((ext_vector_type(8)))short;
using s16x4=__attribute__((ext_vector_type(4)))short;
using f32x16=__attribute__((ext_vector_type(16)))float;
using u32x4=__attribute__((ext_vector_type(4)))unsigned;
constexpr int D=64,QP=512,KP=128;
constexpr int NW=8,QBLK=32,QB=QBLK*NW,KVBLK=64;
__device__ __forceinline__ int crow(int r,int hi){return (r&3)+8*(r>>2)+4*hi;}
#define SBAR() __builtin_amdgcn_sched_barrier(0)
constexpr int NSLOT=3, SLOTB=8192;
constexpr int LDS_K=0, LDS_V=NSLOT*SLOTB, LDS_WS=2*NSLOT*SLOTB, LDS_OST=LDS_WS+NW*64*4, LDS_BYTES=LDS_OST+NW*4096;
__device__ __forceinline__ void glds16(const void*gsrc,unsigned lds_dst){unsigned keep;
  asm volatile("s_mov_b32 %0, m0\n\ts_mov_b32 m0, %2\n\ts_nop 0\n\tglobal_load_lds_dwordx4 %1, off\n\ts_mov_b32 m0, %0":"=&s"(keep):"v"(gsrc),"s"(lds_dst):"memory");}
__device__ __forceinline__ float max3f(float a,float b,float c){float r;asm("v_max3_f32 %0, %1, %2, %3":"=v"(r):"v"(a),"v"(b),"v"(c));return r;}
__device__ __forceinline__ float max2f(float a,float b){float r;asm("v_max_f32_e32 %0, %1, %2":"=v"(r):"v"(a),"v"(b));return r;}
__device__ __forceinline__ float fadd_s(float a,float b){float r;asm("v_add_f32_e32 %0, %1, %2":"=v"(r):"v"(a),"v"(b));return r;}
__device__ __forceinline__ float fsub_s(float a,float b){float r;asm("v_sub_f32_e32 %0, %1, %2":"=v"(r):"v"(a),"v"(b));return r;}
typedef float f32x2_t __attribute__((ext_vector_type(2))); typedef __bf16 bf16x2_t __attribute__((ext_vector_type(2)));
__device__ __forceinline__ unsigned cvtpk_s(float lo,float hi){f32x2_t v={lo,hi};bf16x2_t b=__builtin_convertvector(v,bf16x2_t);return __builtin_bit_cast(unsigned,b);}
#define WAIT_BAR(N) asm volatile("s_waitcnt vmcnt(" #N ") lgkmcnt(0)\n\ts_barrier":::"memory")

__device__ __forceinline__ void qkt(f32x16&p0,f32x16&p1,const char*Kslot,const bf16x8*qr,const f32x16&negm,int r32,int hi){
  const char*kb=Kslot+hi*1024+r32*16;
  #pragma unroll
  for(int d0=0;d0<4;++d0){
    const bf16x8 b0=*reinterpret_cast<const bf16x8*>(kb+d0*2048);
    const bf16x8 b1=*reinterpret_cast<const bf16x8*>(kb+d0*2048+512);
    if(d0==0){p0=__builtin_amdgcn_mfma_f32_32x32x16_bf16(b0,qr[0],negm,0,0,0);p1=__builtin_amdgcn_mfma_f32_32x32x16_bf16(b1,qr[0],negm,0,0,0);}
    else{p0=__builtin_amdgcn_mfma_f32_32x32x16_bf16(b0,qr[d0],p0,0,0,0);p1=__builtin_amdgcn_mfma_f32_32x32x16_bf16(b1,qr[d0],p1,0,0,0);}}
}
typedef __attribute__((address_space(3))) const char* lds_cptr;
typedef short v4i16_t __attribute__((ext_vector_type(4)));
__device__ __forceinline__ void kload8(bf16x8*kf,lds_cptr kp){
  kf[0]=*(const __attribute__((address_space(3))) bf16x8*)(kp);      kf[1]=*(const __attribute__((address_space(3))) bf16x8*)(kp+512);
  kf[2]=*(const __attribute__((address_space(3))) bf16x8*)(kp+2048); kf[3]=*(const __attribute__((address_space(3))) bf16x8*)(kp+2560);
  kf[4]=*(const __attribute__((address_space(3))) bf16x8*)(kp+4096); kf[5]=*(const __attribute__((address_space(3))) bf16x8*)(kp+4608);
  kf[6]=*(const __attribute__((address_space(3))) bf16x8*)(kp+6144); kf[7]=*(const __attribute__((address_space(3))) bf16x8*)(kp+6656);
}
__device__ __forceinline__ void kload2(bf16x8*kf,lds_cptr kp,int j){ kf[2*j]=*(const __attribute__((address_space(3))) bf16x8*)(kp+j*2048); kf[2*j+1]=*(const __attribute__((address_space(3))) bf16x8*)(kp+j*2048+512); }
__device__ __forceinline__ s16x4 vtr(lds_cptr p){ return __builtin_bit_cast(s16x4,__builtin_amdgcn_ds_read_tr16_b64_v4i16((__attribute__((address_space(3))) v4i16_t*)p)); }
__device__ __forceinline__ float rowmax(const f32x16&p0,const f32x16&p1){
  float a=max3f(p0[0],p0[1],p1[0]),b=max3f(p0[2],p0[3],p1[1]);a=max3f(a,p1[2],p1[3]);
  #pragma unroll
  for(int r=4;r<16;r+=4){a=max3f(a,p0[r],p0[r+1]);b=max3f(b,p0[r+2],p0[r+3]);a=max3f(a,p1[r],p1[r+1]);b=max3f(b,p1[r+2],p1[r+3]);}
  const float m=max2f(a,b);
  auto rr=__builtin_amdgcn_permlane32_swap(__float_as_uint(m),__float_as_uint(m),false,false);
  return max2f(__uint_as_float(rr[0]),__uint_as_float(rr[1]));
}
__device__ __forceinline__ void pv(f32x16*o,int vb,bf16x8 pa0,bf16x8 pa1,bf16x8 pa2,bf16x8 pa3){
  #pragma unroll
  for(int d0=0;d0<2;++d0){s16x4 lo[4],hi[4];
    #pragma unroll
    for(int ks=0;ks<4;++ks){
      asm volatile("ds_read_b64_tr_b16 %0,%1 offset:%c2":"=&v"(lo[ks]):"v"(vb),"i"(d0*4096+ks*1024):"memory");
      asm volatile("ds_read_b64_tr_b16 %0,%1 offset:%c2":"=&v"(hi[ks]):"v"(vb),"i"(d0*4096+ks*1024+512):"memory");}
    asm volatile("s_waitcnt lgkmcnt(0)":::"memory");SBAR();
    #define PK(k) (bf16x8){lo[k][0],lo[k][1],lo[k][2],lo[k][3],hi[k][0],hi[k][1],hi[k][2],hi[k][3]}
    o[d0]=__builtin_amdgcn_mfma_f32_32x32x16_bf16(pa0,PK(0),o[d0],0,0,0);
    o[d0]=__builtin_amdgcn_mfma_f32_32x32x16_bf16(pa1,PK(1),o[d0],0,0,0);
    o[d0]=__builtin_amdgcn_mfma_f32_32x32x16_bf16(pa2,PK(2),o[d0],0,0,0);
    o[d0]=__builtin_amdgcn_mfma_f32_32x32x16_bf16(pa3,PK(3),o[d0],0,0,0);
    #undef PK
  }
}
#define ATTN_STORE16(p,v) (*(u32x4*)(p)=(v))
template<int THRL> __device__ __forceinline__ void attn_unit(int b,int h,int qb,const bf16*Q,const bf16*__restrict__ K,const bf16*__restrict__ V,bf16*O,char*shm,float m2){
  const int tid=threadIdx.x,lane=tid&63,r32=lane&31,hi=lane>>5; const int wid=__builtin_amdgcn_readfirstlane(tid>>6);
  const long rowbase=(long)b*SEQ; const int q0=qb*QB; const int kvh=h>>2;
  const bf16*Qw=Q+(rowbase+q0+wid*QBLK)*QP+h*D;
  const bf16*Kh=K+rowbase*KP+kvh*D,*Vh=V+rowbase*KP+kvh*D;
  const unsigned lds0=(unsigned)(uintptr_t)shm;
  float*wsf=(float*)(shm+LDS_WS)+wid*64;
  const bf16*ksrc=Kh+(long)lane*KP+wid*8;
  const bf16*vsrc=Vh+(long)(16*(wid&3)+(lane>>2))*KP+(wid>>2)*32+(lane&3)*8;
  const unsigned kdst=lds0+LDS_K+wid*1024, vdst=lds0+LDS_V+wid*1024;
  #define DMA_K(t,slot) glds16(ksrc+(long)(t)*KVBLK*KP,(unsigned)__builtin_amdgcn_readfirstlane(kdst+(slot)))
  #define DMA_V(t,slot) glds16(vsrc+(long)(t)*KVBLK*KP,(unsigned)__builtin_amdgcn_readfirstlane(vdst+(slot)))
  const int vb0=(int)(lds0+LDS_V)+((lane>>4)&1)*32+(lane&3)*8+(4*hi+((lane&15)>>2))*64;
  const char*Kbase=shm+LDS_K; bf16x8 kf[8];
  const lds_cptr shm3=(lds_cptr)shm; const lds_cptr kp0=shm3+LDS_K+hi*1024+r32*16; const lds_cptr vp0=shm3+LDS_V+((lane>>4)&1)*32+(lane&3)*8+(4*hi+((lane&15)>>2))*64;
  constexpr int NT=SEQ/KVBLK;
  if(wid>=4)__builtin_amdgcn_s_setprio(1);
  DMA_K(0,0);DMA_V(0,0);DMA_K(1,SLOTB);
  bf16x8 qr[4];
  #pragma unroll
  for(int d0=0;d0<4;++d0)qr[d0]=*reinterpret_cast<const bf16x8*>(&Qw[(long)r32*QP+d0*16+hi*8]);
  float l_reg=0.f;f32x16 o[2];o[0]=f32x16{};o[1]=f32x16{};f32x16 negm;
  _Pragma("unroll") for(int r=0;r<16;++r)negm[r]=-m2;
  asm volatile("":"+v"(negm));
  #define START(P0,P1) do{ _Pragma("unroll") for(int r=0;r<16;++r)P0[r]=__builtin_amdgcn_exp2f(P0[r]); }while(0)
  #define RESC() do{}while(0)
  f32x16 pA0,pA1,pB0,pB1;
  int sl_prev=0,sl_cur=0,sl_next=SLOTB;
  #define ROT() do{sl_prev=sl_cur;sl_cur=sl_next;sl_next=(sl_next==(NSLOT-1)*SLOTB)?0:sl_next+SLOTB;}while(0)
  DMA_K(2,2*SLOTB);
  WAIT_BAR(3);
  qkt(pA0,pA1,Kbase,qr,negm,r32,hi);asm volatile("s_nop 15\n\ts_nop 7":"+v"(pA0),"+v"(pA1));
  START(pA0,pA1);
  _Pragma("unroll") for(int r=0;r<16;++r)pA1[r]=__builtin_amdgcn_exp2f(pA1[r]);
  WAIT_BAR(0);
  DMA_K(3,0);DMA_V(1,SLOTB);
  ROT();
  kload8(kf,kp0+sl_cur);
  WAIT_BAR(2);
  s16x4 vlo[8],vhi[8]; u32x4 pw0,pw1,pw2,pw3;
  #define PKW(P,B) cvtpk_s(P[B],P[B+1])
  #define PAF(k) __builtin_bit_cast(bf16x8,pw##k)
  #define VFR(i) (bf16x8){vlo[i][0],vlo[i][1],vlo[i][2],vlo[i][3],vhi[i][0],vhi[i][1],vhi[i][2],vhi[i][3]}
  #define PIN(x) asm volatile("":"+v"(x))
  #define MX3(a,b,c) __builtin_fmaxf(__builtin_fmaxf((a),(b)),(c))
  #define GAPA(MF,A0,A1,A2,A3,W0,W1,PW) do{ MF; sacc+=A0; sacc+=A1; sacc+=A2; sacc+=A3; PIN(sacc); W0; W1; PIN(PW); SBAR(); }while(0)
  #define EX(v) __builtin_amdgcn_exp2f(v)
  #define GAPB(MF,X,B) do{ MF; X[B]=EX(X[B]); X[B+1]=EX(X[B+1]); X[B+2]=EX(X[B+2]); X[B+3]=EX(X[B+3]); PIN(X); SBAR(); }while(0)
  #define VRD(i) do{ vlo[i]=vtr(vp_+(((i)>>2)*4096+((i)&3)*1024)); vhi[i]=vtr(vp_+(((i)>>2)*4096+((i)&3)*1024+512)); }while(0)
  #define KRD(G,j) do{ if(G){ kload2(kf,kp0+sl_next,j); SBAR(); } }while(0)
  #define STEP(C0,C1,P0,P1,t,GK,GV,GL) do{ SBAR(); \
    const lds_cptr vp_=vp0+sl_prev; \
    VRD(0); SBAR(); float sacc=(P0[0]+P0[1]); \
    GAPA(C0=__builtin_amdgcn_mfma_f32_32x32x16_bf16(kf[0],qr[0],negm,0,0,0), P0[2],P0[3],P0[4],P0[5],     pw0[0]=PKW(P0,0), pw0[1]=PKW(P0,2), pw0); \
    VRD(4); SBAR(); GAPA(C1=__builtin_amdgcn_mfma_f32_32x32x16_bf16(kf[1],qr[0],negm,0,0,0), P0[6],P0[7],P0[8],P0[9],     pw0[2]=PKW(P0,4), pw0[3]=PKW(P0,6), pw0); \
    VRD(1); SBAR(); GAPA(C0=__builtin_amdgcn_mfma_f32_32x32x16_bf16(kf[2],qr[1],C0,0,0,0),   P0[10],P0[11],P0[12],P0[13], pw1[0]=PKW(P0,8), pw1[1]=PKW(P0,10), pw1); \
    VRD(5); SBAR(); GAPA(C1=__builtin_amdgcn_mfma_f32_32x32x16_bf16(kf[3],qr[1],C1,0,0,0),   P0[14],P0[15],P1[0],P1[1],   pw1[2]=PKW(P0,12),pw1[3]=PKW(P0,14), pw1); \
    VRD(2); SBAR(); GAPA(C0=__builtin_amdgcn_mfma_f32_32x32x16_bf16(kf[4],qr[2],C0,0,0,0),   P1[2],P1[3],P1[4],P1[5],     pw2[0]=PKW(P1,0), pw2[1]=PKW(P1,2), pw2); \
    VRD(6); SBAR(); GAPA(C1=__builtin_amdgcn_mfma_f32_32x32x16_bf16(kf[5],qr[2],C1,0,0,0),   P1[6],P1[7],P1[8],P1[9],     pw2[2]=PKW(P1,4), pw2[3]=PKW(P1,6), pw2); \
    VRD(3); SBAR(); GAPA(C0=__builtin_amdgcn_mfma_f32_32x32x16_bf16(kf[6],qr[3],C0,0,0,0),   P1[10],P1[11],P1[12],P1[13], pw3[0]=PKW(P1,8), pw3[1]=PKW(P1,10), pw3); \
    VRD(7); SBAR(); GAPA(C1=__builtin_amdgcn_mfma_f32_32x32x16_bf16(kf[7],qr[3],C1,0,0,0),   P1[14],P1[15],0.f,0.f,       pw3[2]=PKW(P1,12),pw3[3]=PKW(P1,14), pw3); \
    l_reg+=sacc; \
    if(GK){DMA_K((t)+3,sl_cur);} if(GV){DMA_V((t)+1,sl_next);} \
    SBAR(); \
    GAPB(o[0]=__builtin_amdgcn_mfma_f32_32x32x16_bf16(PAF(0),VFR(0),o[0],0,0,0), C0,0); \
    GAPB(o[1]=__builtin_amdgcn_mfma_f32_32x32x16_bf16(PAF(0),VFR(4),o[1],0,0,0), C0,4); \
    KRD(GL,0); GAPB(o[0]=__builtin_amdgcn_mfma_f32_32x32x16_bf16(PAF(1),VFR(1),o[0],0,0,0), C0,8); \
    KRD(GL,1); GAPB(o[1]=__builtin_amdgcn_mfma_f32_32x32x16_bf16(PAF(1),VFR(5),o[1],0,0,0), C0,12); \
    KRD(GL,2); GAPB(o[0]=__builtin_amdgcn_mfma_f32_32x32x16_bf16(PAF(2),VFR(2),o[0],0,0,0), C1,0); \
    KRD(GL,3); GAPB(o[1]=__builtin_amdgcn_mfma_f32_32x32x16_bf16(PAF(2),VFR(6),o[1],0,0,0), C1,4); \
    GAPB(o[0]=__builtin_amdgcn_mfma_f32_32x32x16_bf16(PAF(3),VFR(3),o[0],0,0,0), C1,8); \
    GAPB(o[1]=__builtin_amdgcn_mfma_f32_32x32x16_bf16(PAF(3),VFR(7),o[1],0,0,0), C1,12); \
    }while(0)
  int t=1;
  for(;t+5<NT;t+=2){
    STEP(pB0,pB1,pA0,pA1,t,true,true,true);     WAIT_BAR(2); RESC(); ROT();
    STEP(pA0,pA1,pB0,pB1,t+1,true,true,true);   WAIT_BAR(2); RESC(); ROT();
  }
  #define ENDW(tt) do{ if((tt)+3<NT){WAIT_BAR(2);} else if((tt)+2<NT){WAIT_BAR(1);} else {WAIT_BAR(0);} }while(0)
  for(;t+1<NT;t+=2){
    STEP(pB0,pB1,pA0,pA1,t,(t+3<NT),(t+1<NT),(t+1<NT));       ENDW(t);   RESC(); ROT();
    STEP(pA0,pA1,pB0,pB1,t+1,(t+4<NT),(t+2<NT),(t+2<NT));     ENDW(t+1); RESC(); ROT();
  }
  STEP(pB0,pB1,pA0,pA1,NT-1,false,false,false); RESC();
  { float sacc=pB0[0]+pB0[1]; _Pragma("unroll") for(int r=2;r<16;++r)sacc+=pB0[r]; _Pragma("unroll") for(int r=0;r<16;++r)sacc+=pB1[r]; l_reg+=sacc;
    pw0=(u32x4){PKW(pB0,0),PKW(pB0,2),PKW(pB0,4),PKW(pB0,6)};pw1=(u32x4){PKW(pB0,8),PKW(pB0,10),PKW(pB0,12),PKW(pB0,14)};pw2=(u32x4){PKW(pB1,0),PKW(pB1,2),PKW(pB1,4),PKW(pB1,6)};pw3=(u32x4){PKW(pB1,8),PKW(pB1,10),PKW(pB1,12),PKW(pB1,14)};
    SBAR(); pv(o,vb0+sl_cur,PAF(0),PAF(1),PAF(2),PAF(3)); }
  #undef PKW
  #undef PAF
  #undef VFR
  #undef PIN
  #undef MX3
  #undef GAPA
  #undef GAPB
  #undef EX
  #undef VRD
  #undef KRD
  #undef STEP
  #undef ENDW
  {auto rr=__builtin_amdgcn_permlane32_swap(__float_as_uint(l_reg),__float_as_uint(l_reg),false,false);l_reg=__uint_as_float(rr[0])+__uint_as_float(rr[1]);}
  if(hi==0)wsf[32+r32]=l_reg;asm volatile("s_waitcnt lgkmcnt(0)":::"memory");
  float rli[16];
  #pragma unroll
  for(int r=0;r<16;++r)rli[r]=__builtin_amdgcn_rcpf(wsf[32+crow(r,hi)]);
  bf16*Ow=O+(rowbase+q0+wid*QBLK)*QP+h*D;
  { bf16*stg=(bf16*)(shm+LDS_OST)+wid*2048;
    #pragma unroll
    for(int r=0;r<16;++r){const int orow=crow(r,hi);
      #pragma unroll
      for(int d0=0;d0<2;++d0)stg[orow*64+d0*32+r32]=__float2bfloat16(o[d0][r]*rli[r]);}
    asm volatile("s_waitcnt lgkmcnt(0)":::"memory");
    #pragma unroll
    for(int i=0;i<4;++i){const int row=i*8+(lane>>3),ch=lane&7; const u32x4 v=*(const u32x4*)(stg+row*64+ch*8); ATTN_STORE16(Ow+(long)row*QP+ch*8,v);} }
  __builtin_amdgcn_s_setprio(0);
  asm volatile("s_waitcnt lgkmcnt(0)\n\ts_barrier":::"memory");
  #undef DMA_K
  #undef DMA_V
  #undef START
  #undef RESC
  #undef ROT
}
constexpr int ATTN_LDS_BYTES=LDS_BYTES;
#undef SBAR
#undef WAIT_BAR
}

constexpr int NWAVES = 8;
constexpr size_t MiB = 1u << 20;
constexpr size_t WS_SS = 0;
constexpr size_t WS_WGLU = 1 * MiB, WS_WPP = 1 * MiB + 512 * 1024, WS_WAB = 2 * MiB, WS_WSB = 3 * MiB, WS_WOUT = 4 * MiB, WS_WPG = 6 * MiB;
constexpr size_t WS_WIN = 8 * MiB, WS_W1GU = 15 * MiB, WS_W1D = 26 * MiB, WS_W2GU = 32 * MiB, WS_W2D = 43 * MiB;
constexpr size_t WS_WEND = 49 * MiB, WS_WBIG = 53 * MiB, WS_PB = 61 * MiB, WS_XB = 69 * MiB;
constexpr size_t WS_ACT = 101 * MiB;
constexpr size_t WS_Q = 101 * MiB, WS_K = 117 * MiB, WS_V = 121 * MiB, WS_GATES = 125 * MiB, WS_AUG = 189 * MiB, WS_E = 221 * MiB;
constexpr size_t WS_Z = 221 * MiB, WS_Z2 = 237 * MiB, WS_MG = 189 * MiB, WS_CTL = 253 * MiB, CTL_BYTES = 65536, WS_END = 254 * MiB;
constexpr int RING_BYTES = 131072, MISC_OFF = RING_BYTES + 320, LDS_BYTES = 147456;

typedef unsigned short bf16;
typedef float f32x4 __attribute__((ext_vector_type(4)));
typedef unsigned v4u __attribute__((ext_vector_type(4)));
typedef unsigned v2u __attribute__((ext_vector_type(2)));
#define LDS_WAIT() asm volatile("s_waitcnt lgkmcnt(0)" ::: "memory")
__device__ __forceinline__ unsigned f2bf(float f) { unsigned u = __builtin_bit_cast(unsigned, f); return (u + 0x7fffu + ((u >> 16) & 1u)) >> 16; }
__device__ __forceinline__ unsigned pk2(float lo, float hi) { return f2bf(lo) | (f2bf(hi) << 16); }
__device__ __forceinline__ float wave_sum(float v) {
#pragma unroll
    for (int o = 1; o < 64; o <<= 1) v += __shfl_xor(v, o);
    return v;
}
__device__ __forceinline__ void p0_transpose_item(const float* W, int K, int N, bf16* WT, const float* gain, int mode, LAS float* scr, int item, int lane) {
    const int nblk = N / 64, kb = item / nblk, nb = item % nblk, k0 = 64 * kb, n00 = 64 * nb;
    f32x4 w[2][8]; float gn[8];
#pragma unroll
    for (int hf = 0; hf < 2; ++hf)
#pragma unroll
        for (int i = 0; i < 8; ++i) w[hf][i] = __builtin_nontemporal_load((const f32x4*)(W + (size_t)(k0 + (lane >> 3) + 8 * i) * N + n00 + 32 * hf + 4 * (lane & 7)));
#pragma unroll
    for (int i = 0; i < 8; ++i) gn[i] = gain ? gain[k0 + (lane >> 3) + 8 * i] : 1.0f;
#pragma unroll
    for (int hf = 0; hf < 2; ++hf) { const int n0 = n00 + 32 * hf;
#pragma unroll
      for (int i = 0; i < 8; ++i) { const int kk = (lane >> 3) + 8 * i; LAS float* d = scr + kk * 33 + 4 * (lane & 7);
          d[0] = w[hf][i].x * gn[i]; d[1] = w[hf][i].y * gn[i]; d[2] = w[hf][i].z * gn[i]; d[3] = w[hf][i].w * gn[i]; }
    LDS_WAIT(); asm volatile("" ::: "memory");
    const int c = lane & 7;
#pragma unroll
    for (int j = 0; j < 4; ++j) { const int n = (lane >> 3) + 8 * j; const LAS float* s = scr + (8 * c) * 33 + n;
        v4u o; o.x = pk2(s[0 * 33], s[1 * 33]); o.y = pk2(s[2 * 33], s[3 * 33]); o.z = pk2(s[4 * 33], s[5 * 33]); o.w = pk2(s[6 * 33], s[7 * 33]);
        const int ng = n0 + n; int row;
        if (mode == 0) row = ng;
        else if (mode == 3) {
            if (ng < 512) row = (ng & ~255) + 128 * ((ng >> 5) & 1) + 32 * ((ng >> 6) & 3) + (ng & 31);
            else if (ng < 640) row = 512 + 128 * ((ng >> 5) & 1) + 32 * ((ng >> 6) & 1) + (ng & 31);
            else if (ng < 768) { const int vi = ng - 640; row = 512 + 128 * ((vi >> 5) & 1) + 32 * (2 + (vi >> 6)) + (vi & 31); }
            else row = ng; }
        else row = (ng >> 7) * 256 + (ng & 127) + (mode == 2 ? 128 : 0);
        *(v4u*)(WT + (size_t)row * K + k0 + 8 * c) = o; }
    LDS_WAIT(); asm volatile("" ::: "memory"); }
}
struct cplx { float re, im; };
__device__ __forceinline__ cplx cmul(cplx a, cplx b) { return cplx{a.re * b.re - a.im * b.im, a.re * b.im + a.im * b.re}; }
__device__ __forceinline__ void sincos_rev(float rev, float& s, float& c) { const float f = rev - floorf(rev); s = __builtin_amdgcn_sinf(f); c = __builtin_amdgcn_cosf(f); }

__device__ __forceinline__ void s5_gen(LAS unsigned char* lds, int g, int part, int tid, const float* lam_re, const float* lam_im, const float* log_step, const float* b_re, const float* b_im,
                                       const float* c_re, const float* c_im, const float* dskip, bf16* Wend, bf16* Wbig) {
    LAS float* L = (LAS float*)lds;
    LAS float* Bb = L + 2 * 17 * 64 * 2;
    LAS float* Cc = Bb + 2 * 1024 * 2;
    LAS float* Kt = Cc + 2 * 1024 * 2;
    for (int idx = tid; idx < 2 * 17 * 64; idx += 512) { const int dir = idx / (17 * 64), j = (idx / 64) % 17, p = idx & 63;
        const float lr = lam_re[(dir * 32 + g) * 64 + p], li = lam_im[(dir * 32 + g) * 64 + p], delta = expf(log_step[dir * 32 + g]);
        const float mag = expf((float)j * delta * lr); float s, c; sincos_rev((float)j * delta * li * 0.15915494309189535f, s, c);
        L[idx * 2] = mag * c; L[idx * 2 + 1] = mag * s; }
    for (int idx = tid; idx < 2 * 1024; idx += 512) { const int dir = idx >> 10, r = idx & 1023;
        { const int p = r >> 4; const float lr = lam_re[(dir * 32 + g) * 64 + p], li = lam_im[(dir * 32 + g) * 64 + p], delta = expf(log_step[dir * 32 + g]);
          const float mag = expf(delta * lr); float s, c; sincos_rev(delta * li * 0.15915494309189535f, s, c);
          const float nr = mag * c - 1.0f, ni = mag * s, den = 1.0f / (lr * lr + li * li);
          const cplx coef{(nr * lr + ni * li) * den, (ni * lr - nr * li) * den};
          const size_t src = ((size_t)(dir * 32 + g) * 64) * 16 + r;
          const cplx bb = cmul(coef, cplx{b_re[src], b_im[src]});
          Bb[idx * 2] = bb.re; Bb[idx * 2 + 1] = bb.im; }
        { const size_t src = ((size_t)(dir * 32 + g) * 16) * 64 + r;
          Cc[idx * 2] = c_re[src]; Cc[idx * 2 + 1] = c_im[src]; } }
    __syncthreads();
    { const int dir = tid >> 8, h = (tid >> 4) & 15, h2 = tid & 15; float acc[16];
#pragma unroll
      for (int j = 0; j < 16; ++j) acc[j] = 0.f;
      for (int p = 0; p < 64; ++p) { const cplx cc{Cc[((dir * 16 + h) * 64 + p) * 2], Cc[((dir * 16 + h) * 64 + p) * 2 + 1]}, bb{Bb[((dir * 64 + p) * 16 + h2) * 2], Bb[((dir * 64 + p) * 16 + h2) * 2 + 1]};
          const cplx cb = cmul(cc, bb);
#pragma unroll
          for (int j = 0; j < 16; ++j) { const float lr = L[((dir * 17 + j) * 64 + p) * 2], li = L[((dir * 17 + j) * 64 + p) * 2 + 1]; acc[j] += cb.re * lr - cb.im * li; } }
#pragma unroll
      for (int j = 0; j < 16; ++j) Kt[(dir * 16 + j) * 256 + h * 16 + h2] = acc[j]; }
    __syncthreads();
    for (int e = tid; e < 64 * 256; e += 512) { const int n = 64 * part + (e >> 8), kp = e & 255, tl = n >> 4, h = n & 15; float v[2];
#pragma unroll
        for (int s = 0; s < 2; ++s) { const int k = 2 * kp + s; float val;
            if (k < 256) { const int tl2 = k >> 4, h2 = k & 15; val = 0.f;
                if (tl2 <= tl) val += Kt[(0 * 16 + (tl - tl2)) * 256 + h * 16 + h2];
                if (tl2 >= tl) val += Kt[(1 * 16 + (tl2 - tl)) * 256 + h * 16 + h2];
                if (k == n) val += dskip[g * 16 + h]; }
            else { const int kk = k - 256, dir = kk >> 7, part = (kk >> 6) & 1, p = kk & 63, ex = dir ? 16 - tl : tl + 1;
                const cplx cc{Cc[((dir * 16 + h) * 64 + p) * 2], Cc[((dir * 16 + h) * 64 + p) * 2 + 1]}, ll{L[((dir * 17 + ex) * 64 + p) * 2], L[((dir * 17 + ex) * 64 + p) * 2 + 1]};
                const cplx x = cmul(cc, ll); val = part ? -x.im : x.re; }
            v[s] = val; }
        *(unsigned*)(Wbig + ((size_t)g * 256 + n) * 512 + 2 * kp) = pk2(v[0], v[1]); }
    for (int e = tid; e < 64 * 128; e += 512) { const int n = 64 * part + (e >> 7), kp = e & 127, dir = n >> 7, prt = (n >> 6) & 1, p = n & 63; float v[2];
#pragma unroll
        for (int s = 0; s < 2; ++s) { const int k = 2 * kp + s, tl = k >> 4, h = k & 15, ex = dir ? tl : 15 - tl;
            const cplx ll{L[((dir * 17 + ex) * 64 + p) * 2], L[((dir * 17 + ex) * 64 + p) * 2 + 1]}, bb{Bb[((dir * 64 + p) * 16 + h) * 2], Bb[((dir * 64 + p) * 16 + h) * 2 + 1]};
            const cplx x = cmul(ll, bb); v[s] = prt ? x.im : x.re; }
        *(unsigned*)(Wend + ((size_t)g * 256 + n) * 256 + 2 * kp) = pk2(v[0], v[1]); }
    __syncthreads();
}

#define XB_TMO      128
#define XB_XCNT(j)  (256  + 64 * (j))
#define XB_XSUB(j)  (1280 + 64 * (j))
#define XB_XGEN(j)  (2304 + 64 * (j))
#define XB_TOP      3328
#define XB_TOPGEN   3392
#define XCD_BAR_WORDS 3456
#define XB_SPIN_CAP (1u << 18)
__device__ __forceinline__ unsigned xb_ld(unsigned* p)              { return __hip_atomic_load(p, __ATOMIC_RELAXED, __HIP_MEMORY_SCOPE_AGENT); }
__device__ __forceinline__ unsigned xb_add(unsigned* p, unsigned v) { return __hip_atomic_fetch_add(p, v, __ATOMIC_RELAXED, __HIP_MEMORY_SCOPE_AGENT); }
__device__ __forceinline__ unsigned xb_xcc_id() { return (unsigned)__builtin_amdgcn_s_getreg((3 << 11) | 20) & 0xFu; }
#define XB_SPIN(cond, bar) do { unsigned _sp = 0; while (cond) { __builtin_amdgcn_s_sleep(1); \
    if ((++_sp & 255u) == 0u) { if (xb_ld(&(bar)[XB_TMO])) break; if (_sp > XB_SPIN_CAP) { atomicAdd(&(bar)[XB_TMO], 1u); break; } } } } while (0)
struct XcdBarrier { unsigned* bar; unsigned x; volatile LAS unsigned* st; };
__device__ __forceinline__ XcdBarrier xcd_barrier_post(unsigned* bar, volatile LAS unsigned* st) {
    XcdBarrier b; b.bar = bar; b.x = xb_xcc_id(); b.st = st;
    if (threadIdx.x == 0) (void)xb_add(&bar[XB_XCNT(b.x)], 1u);
    return b;
}
__device__ __forceinline__ void xcd_barrier_complete(unsigned* bar, unsigned x, unsigned& nloc, unsigned& nx) {
    const unsigned G = gridDim.x * gridDim.y * gridDim.z;
    unsigned sum, cnt, mine, sp = 0u;
    for (;;) {
        sum = 0u; cnt = 0u; mine = 0u;
#pragma unroll
        for (unsigned j = 0; j < 16; ++j) { const unsigned c = xb_ld(&bar[XB_XCNT(j)]); sum += c; cnt += (c > 0u) ? 1u : 0u; mine = (j == x) ? c : mine; }
        if (sum == G) break;
        __builtin_amdgcn_s_sleep(1);
        if ((++sp & 255u) == 0u) { if (xb_ld(&bar[XB_TMO])) break; if (sp > XB_SPIN_CAP) { atomicAdd(&bar[XB_TMO], 1u); break; } }
    }
    nloc = mine > 0u ? mine : 1u; nx = cnt > 0u ? cnt : 1u;
}
__device__ __forceinline__ void xcd_barrier(const XcdBarrier& b) {
    asm volatile("s_waitcnt vmcnt(0)" ::: "memory");
    __syncthreads();
    if (threadIdx.x == 0) {
        unsigned* bar = b.bar;
        __builtin_amdgcn_s_waitcnt(0);
        unsigned nloc = b.st[0], nx = b.st[1];
        if (nloc == 0u) { xcd_barrier_complete(bar, b.x, nloc, nx); b.st[0] = nloc; b.st[1] = nx; }
        const unsigned old = xb_add(&bar[XB_XSUB(b.x)], 1u);
        const unsigned gen = old / nloc;
        if (old + 1u == (gen + 1u) * nloc) {
            __builtin_amdgcn_fence(__ATOMIC_RELEASE, "agent");
            asm volatile("s_waitcnt vmcnt(0)" ::: "memory");
            const unsigned og = xb_add(&bar[XB_TOP], 1u);
            const unsigned tg = og / nx;
            if (og + 1u == (tg + 1u) * nx) xb_add(&bar[XB_TOPGEN], 1u);
            else XB_SPIN(xb_ld(&bar[XB_TOPGEN]) == tg, bar);
            __builtin_amdgcn_fence(__ATOMIC_ACQUIRE, "agent");
            xb_add(&bar[XB_XGEN(b.x)], 1u);
            asm volatile("s_waitcnt vmcnt(0)" ::: "memory");
        } else {
            XB_SPIN(xb_ld(&bar[XB_XGEN(b.x)]) == gen, bar);
            __builtin_amdgcn_fence(__ATOMIC_ACQUIRE, "agent");
            asm volatile("s_waitcnt vmcnt(0)" ::: "memory");
        }
    }
    __syncthreads();
}

struct Args { const float* in[30]; float* out; unsigned char* ws; int ph_lo, ph_hi; };
constexpr int N_PHASES = 13;

__global__ void __launch_bounds__(NWAVES * 64, 2) mega_fwd(Args args) {
    __builtin_assume(__builtin_amdgcn_workitem_id_y() == 0); __builtin_assume(__builtin_amdgcn_workitem_id_z() == 0);
    extern __shared__ __attribute__((aligned(16))) unsigned char lds_raw[];
    LAS unsigned char* lds = (LAS unsigned char*)lds_raw;
    cg::grid_group grid = cg::this_grid();
#define OPAQUE_TID() int tid = threadIdx.x; asm volatile("" : "+v"(tid)); const int lane = tid & 63; const int wave = __builtin_amdgcn_readfirstlane(tid >> 6); (void)lane; (void)wave
    const int G = gridDim.x;
    unsigned char* ws = args.ws;
    int bx;
    { volatile LAS unsigned* vb = (volatile LAS unsigned*)(lds + MISC_OFF + 96);
      if (threadIdx.x == 0) { unsigned v = blockIdx.x;
          if (G == 256) { const unsigned xcc = xb_xcc_id() & 7u; const unsigned slot = xb_add((unsigned*)(ws + WS_CTL) + 6144 + 64 * xcc, 1u); v = (slot & 31u) * 8u + xcc; }
          vb[0] = v; }
      __syncthreads(); bx = (int)__builtin_amdgcn_readfirstlane(vb[0]); __syncthreads(); }
    const int vcu = (G % 8 == 0) ? (bx % 8) * (G / 8) + bx / 8 : bx;
    const float* x = args.in[0]; float* out = args.out;
    float* ss0 = (float*)(ws + WS_SS); float* ss1 = ss0 + M; float* ss2 = ss1 + M; float* ss3 = ss2 + M;
    bf16* Wglu = (bf16*)(ws + WS_WGLU); bf16* Wpp = (bf16*)(ws + WS_WPP); bf16* Wab = (bf16*)(ws + WS_WAB); bf16* Wsb = (bf16*)(ws + WS_WSB); bf16* Wout = (bf16*)(ws + WS_WOUT); bf16* Wpg = (bf16*)(ws + WS_WPG);
    bf16* Win = (bf16*)(ws + WS_WIN); bf16* W1gu = (bf16*)(ws + WS_W1GU); bf16* W1d = (bf16*)(ws + WS_W1D); bf16* W2gu = (bf16*)(ws + WS_W2GU); bf16* W2d = (bf16*)(ws + WS_W2D);
    bf16* Wend = (bf16*)(ws + WS_WEND); bf16* Wbig = (bf16*)(ws + WS_WBIG); bf16* PB = (bf16*)(ws + WS_PB); bf16* XB = (bf16*)(ws + WS_XB);
    bf16* ACT = (bf16*)(ws + WS_ACT); bf16* QB_ = (bf16*)(ws + WS_Q); bf16* KB = (bf16*)(ws + WS_K); bf16* VB = (bf16*)(ws + WS_V); bf16* GATES = (bf16*)(ws + WS_GATES);
    bf16* AUG = (bf16*)(ws + WS_AUG); float* EB = (float*)(ws + WS_E); bf16* ZB = (bf16*)out; bf16* Z2B = (bf16*)out + (size_t)M * 512;     bf16* MG = (bf16*)(ws + WS_MG); bf16* PTMP = (bf16*)(ws + WS_AUG);

    const int lo = args.ph_lo, hi = args.ph_hi;
    volatile LAS unsigned* MISC = (volatile LAS unsigned*)(lds + MISC_OFF);
    if (threadIdx.x < 32) MISC[threadIdx.x] = 0u;
    __syncthreads();
    XcdBarrier bar = xcd_barrier_post((unsigned*)(ws + WS_CTL), MISC + 8);
#define IN(k) (lo <= (k) && (k) < hi)
#define SEAM(k) do { if (IN(k) && IN((k) + 1)) xcd_barrier(bar); } while (0)
    if (lo < 0) grid.sync();

    if (IN(0)) {
        OPAQUE_TID();
        const int gw = vcu * NWAVES + wave, NGW = G * NWAVES;
        LAS float* scr = (LAS float*)(lds + wave * 16384);
        constexpr int I_GU = (DM / 64) * (FF / 64), I_D = (FF / 64) * (DM / 64), I_IN = (DM / 64) * (NIN / 64), I_GLU = (512 / 64) * (512 / 64), I_BR = (512 / 64) * (DM / 64), I_SQ = (DM / 64) * (DM / 64), I_PP = (PLE / 64) * (DM / 64);
        for (int it = gw; it < 2 * I_GU; it += NGW) {
            if (it < I_GU) p0_transpose_item(args.in[3], DM, FF, W1gu, args.in[2], 1, scr, it, lane);
            else p0_transpose_item(args.in[4], DM, FF, W1gu, args.in[2], 2, scr, it - I_GU, lane);
        }
        { const int rbase = (G == 256) ? 2048 * (bx & 7) + 64 * (bx >> 3) : -1;
          if (rbase >= 0) {
#pragma unroll 1
            for (int it = 0; it < 4; ++it) { const int m = rbase + wave * 8 + 2 * it; const f32x4* xr = (const f32x4*)(x + (size_t)m * DM) + lane; f32x4 v[8]; float s0 = 0.f, s1 = 0.f;
#pragma unroll
                for (int j = 0; j < 8; ++j) v[j] = __builtin_nontemporal_load(xr + 64 * j);
#pragma unroll
                for (int j = 0; j < 4; ++j) { s0 += (v[j].x * v[j].x + v[j].y * v[j].y) + (v[j].z * v[j].z + v[j].w * v[j].w); s1 += (v[j + 4].x * v[j + 4].x + v[j + 4].y * v[j + 4].y) + (v[j + 4].z * v[j + 4].z + v[j + 4].w * v[j + 4].w); }
                s0 = wave_sum(s0); s1 = wave_sum(s1); if (lane == 0) { ss0[m] = s0; ss0[m + 1] = s1; }
                v2u* o8 = (v2u*)(XB + (size_t)m * DM) + lane;
#pragma unroll
                for (int j = 0; j < 8; ++j) o8[64 * j] = (v2u){pk2(v[j].x, v[j].y), pk2(v[j].z, v[j].w)}; }
            if (tid < 64) { ss1[rbase + tid] = 0.f; ss2[rbase + tid] = 0.f; ss3[rbase + tid] = 0.f; }
          } else {
            for (int m = gw; m < M; m += NGW) { const f32x4* xr = (const f32x4*)(x + (size_t)m * DM) + lane; f32x4 v[4]; float s0 = 0.f;
#pragma unroll
                for (int j = 0; j < 4; ++j) { v[j] = xr[64 * j]; s0 += (v[j].x * v[j].x + v[j].y * v[j].y) + (v[j].z * v[j].z + v[j].w * v[j].w); }
                s0 = wave_sum(s0); if (lane == 0) ss0[m] = s0;
                v2u* o8 = (v2u*)(XB + (size_t)m * DM) + lane;
#pragma unroll
                for (int j = 0; j < 4; ++j) o8[64 * j] = (v2u){pk2(v[j].x, v[j].y), pk2(v[j].z, v[j].w)}; }
            const int gt = vcu * 512 + tid, NGT = G * 512; const f32x4* pp = (const f32x4*)args.in[1]; v2u* po = (v2u*)PB;
            for (int i = gt; i < M * PLE / 4; i += NGT) { const f32x4 v = pp[i]; po[i] = (v2u){pk2(v.x, v.y), pk2(v.z, v.w)}; }
            for (int i = gt; i < 3 * M; i += NGT) ss1[i] = 0.f; } }
        __syncthreads();
    }
    SEAM(0);
    if (IN(1)) { pg8::Gemm g{XB, W1gu, M, 2 * FF, DM, DM, DM, 0, 0, 1}; pg8::StaticOrder S; S.init(M, 2 * FF, 1, G, bx);
        pg8::EpiSwiglu E{ss0, ACT}; pg8::gemm_phase<pg8::EpiSwiglu, true>(lds, g, S, E);
        if (bx >= 128) {
            OPAQUE_TID(); LAS float* scr = (LAS float*)(lds + wave * 16384);
            constexpr int J_D = (FF / 64) * (DM / 64), J_IN = (DM / 64) * (NIN / 64);
            for (int it = (bx - 128) * NWAVES + wave; it < J_D + J_IN; it += 128 * NWAVES) {
                if (it < J_D) p0_transpose_item(args.in[5], FF, DM, W1d, nullptr, 0, scr, it, lane);
                else p0_transpose_item(args.in[7], DM, NIN, Win, args.in[6], 3, scr, it - J_D, lane); }
            __syncthreads(); } }
    SEAM(1);
    if (IN(2)) { pg8::Gemm g{ACT, W1d, M, DM, FF, 64, FF, 0, 0, 1, (size_t)256 * 64 * 2, (size_t)(FF / 64) * 256 * 64 * 2}; pg8::StaticOrder S; S.init(M, DM, 1, G, bx);
        pg8::EpiResid<true> E{nullptr, XB, ss1, 0.5f}; pg8::gemm_phase<pg8::EpiResid<true>, true>(lds, g, S, E); }
    SEAM(2);
    if (IN(3)) { pg8::Gemm g{XB, Win, M, NIN, DM, DM, DM, 0, 0, 1}; pg8::StaticOrder S; S.init(M, NIN, 1, G, bx);
        pg8::EpiInProj E{ss1, QB_, KB, VB, AUG, (unsigned char*)GATES, args.in[8], args.in[9]}; pg8::gemm_phase<pg8::EpiInProj, true>(lds, g, S, E);
        if (bx >= 64 && bx < 192) { OPAQUE_TID(); s5_gen(lds, (bx - 64) >> 2, (bx - 64) & 3, tid, args.in[10], args.in[11], args.in[12], args.in[13], args.in[14], args.in[15], args.in[16], args.in[17], Wend, Wbig); }
        if (bx >= 192 && G == 256) {
            const int rb = 2048 * (bx & 7) + 256 * ((bx - 192) >> 3);
#pragma unroll 1
            for (int h = 0; h < 2; ++h) { const f32x4* pp = (const f32x4*)args.in[1] + (size_t)(rb + 128 * h) * (PLE / 4) + threadIdx.x; v2u* po = (v2u*)PB + (size_t)(rb + 128 * h) * (PLE / 4) + threadIdx.x; f32x4 v[16];
#pragma unroll
                for (int q = 0; q < 16; ++q) v[q] = __builtin_nontemporal_load(pp + 512 * q);
#pragma unroll
                for (int q = 0; q < 16; ++q) po[512 * q] = (v2u){pk2(v[q].x, v[q].y), pk2(v[q].z, v[q].w)}; } } }
    SEAM(3);
    if (IN(6)) {
        unsigned* scan_done = (unsigned*)(ws + WS_CTL) + 4096;
        if (bx < 64) {
            const int g = bx >> 1, b = bx & 1;
            { int one_ = 1, zero_ = 0, kq_ = 256; asm volatile("" : "+s"(one_), "+s"(zero_), "+s"(kq_)); pg8::Gemm gm{AUG + ((size_t)(g * 1024 + b * 512)) * 512, Wend + (size_t)g * 256 * 256, 512, 256, kq_, 512, 256, 0, 0, 1}; pg8::StaticOrder S; S.init(512, 256, 1, one_, zero_);
              pg8::EpiE E{EB + ((size_t)(g * 1024 + b * 512)) * 256}; pg8::gemm_phase<pg8::EpiE, true>(lds, gm, S, E); }
            __builtin_amdgcn_fence(__ATOMIC_ACQUIRE, "agent"); asm volatile("s_waitcnt vmcnt(0)" ::: "memory");
            OPAQUE_TID();
            const int p = lane, seg = wave;
#pragma unroll 1
            for (int dir = 0; dir < 2; ++dir) {
            const float lr = args.in[10][(dir * 32 + g) * 64 + p], li = args.in[11][(dir * 32 + g) * 64 + p], delta = expf(args.in[12][dir * 32 + g]);
            const float mag = expf(16.0f * delta * lr); float sn, cs; { const double rev = 16.0 * (double)delta * (double)li * 0.15915494309189535; sincos_rev((float)(rev - floor(rev)), sn, cs); }
            const float ar = mag * cs, ai = mag * sn;
            const float* Eb = EB + ((size_t)(g * 1024 + b * 512)) * 256 + dir * 128 + p;
            bf16* Ab = AUG + ((size_t)(g * 1024 + b * 512)) * 512 + 256 + dir * 128 + p;
            float er[64], ei[64];
#pragma unroll
            for (int q = 0; q < 64; ++q) { const int sidx = seg * 64 + q, c = dir ? 511 - sidx : sidx; er[q] = Eb[(size_t)c * 256]; ei[q] = Eb[(size_t)c * 256 + 64]; }
            float sr = 0.f, si = 0.f;
#pragma unroll
            for (int q = 0; q < 64; ++q) { const float nr = ar * sr - ai * si + er[q], ni = ar * si + ai * sr + ei[q]; sr = nr; si = ni; }
            LAS float* segE = (LAS float*)lds;
            segE[(seg * 64 + p) * 2] = sr; segE[(seg * 64 + p) * 2 + 1] = si;
            float br = ar, bi = ai;
#pragma unroll
            for (int q = 0; q < 6; ++q) { const float nr = br * br - bi * bi, ni = 2.0f * br * bi; br = nr; bi = ni; }
            __syncthreads();
            sr = 0.f; si = 0.f;
            for (int v = 0; v < seg; ++v) { const float e0 = segE[(v * 64 + p) * 2], e1 = segE[(v * 64 + p) * 2 + 1]; const float nr = br * sr - bi * si + e0, ni = br * si + bi * sr + e1; sr = nr; si = ni; }
            if (seg == 0) { bf16* z0 = Ab + (size_t)(dir ? 511 : 0) * 512; z0[0] = 0; z0[64] = 0; }
#pragma unroll
            for (int q = 0; q < 64; ++q) { const int sidx = seg * 64 + q, c = dir ? 511 - sidx : sidx; const float nr = ar * sr - ai * si + er[q], ni = ar * si + ai * sr + ei[q]; sr = nr; si = ni;
                const int cd = dir ? c - 1 : c + 1;
                if (cd >= 0 && cd < 512) { Ab[(size_t)cd * 512] = (bf16)f2bf(sr); Ab[(size_t)cd * 512 + 64] = (bf16)f2bf(si); } }
            __syncthreads();
            }
            asm volatile("s_waitcnt vmcnt(0) lgkmcnt(0)" ::: "memory"); __syncthreads();
            if (tid == 0) { __builtin_amdgcn_fence(__ATOMIC_RELEASE, "agent"); asm volatile("s_waitcnt vmcnt(0)" ::: "memory"); __hip_atomic_fetch_add(scan_done, 1u, __ATOMIC_RELAXED, __HIP_MEMORY_SCOPE_AGENT); }
        }
        float m2;
        { const int ln = threadIdx.x & 63; float gq = fabsf(args.in[8][ln]), gk = fabsf(args.in[9][ln]);
#pragma unroll
          for (int o = 1; o < 64; o <<= 1) { gq = fmaxf(gq, __shfl_xor(gq, o)); gk = fmaxf(gk, __shfl_xor(gk, o)); }
          m2 = 8.0f * gq * gk * 1.4426950408889634f * 1.002f; }
        for (int i = 0; i < 2; ++i) { const int u = vcu * 2 + i; if (u < 512) { const int bh = u >> 5, qb = u & 31;
            attn_body::attn_unit<8>(bh >> 3, bh & 7, qb, (const attn_body::bf16*)QB_, (const attn_body::bf16*)KB, (const attn_body::bf16*)VB, (attn_body::bf16*)QB_, (char*)lds_raw, m2); } }
        asm volatile("s_waitcnt vmcnt(0) lgkmcnt(0)" ::: "memory"); __syncthreads();
        if (bx >= 64 && bx < 128) {
            OPAQUE_TID(); LAS float* scr = (LAS float*)(lds + wave * 16384);
            constexpr int J_GU = (DM / 64) * (FF / 64), J_D = (FF / 64) * (DM / 64), J_GLU = (512 / 64) * (512 / 64), J_BR = (512 / 64) * (DM / 64), J_SQ = (DM / 64) * (DM / 64), J_PP = (PLE / 64) * (DM / 64);
            for (int it = (bx - 64) * NWAVES + wave; it < 2 * J_GU + J_D + J_GLU + 2 * J_BR + 2 * J_SQ + J_PP; it += 64 * NWAVES) { int r = it;
                if (r < J_GLU) { p0_transpose_item(args.in[18], 512, 512, Wglu, nullptr, 0, scr, r, lane); continue; } r -= J_GLU;
                if (r < J_BR) { p0_transpose_item(args.in[20], 512, DM, Wab, nullptr, 0, scr, r, lane); continue; } r -= J_BR;
                if (r < J_BR) { p0_transpose_item(args.in[21], 512, DM, Wsb, nullptr, 0, scr, r, lane); continue; } r -= J_BR;
                if (r < J_SQ) { p0_transpose_item(args.in[22], DM, DM, Wout, nullptr, 0, scr, r, lane); continue; } r -= J_SQ;
                if (r < J_GU) { p0_transpose_item(args.in[24], DM, FF, W2gu, args.in[23], 1, scr, r, lane); continue; } r -= J_GU;
                if (r < J_GU) { p0_transpose_item(args.in[25], DM, FF, W2gu, args.in[23], 2, scr, r, lane); continue; } r -= J_GU;
                if (r < J_D) { p0_transpose_item(args.in[26], FF, DM, W2d, nullptr, 0, scr, r, lane); continue; } r -= J_D;
                if (r < J_SQ) { p0_transpose_item(args.in[28], DM, DM, Wpg, args.in[27], 0, scr, r, lane); continue; } r -= J_SQ;
                p0_transpose_item(args.in[29], PLE, DM, Wpp, nullptr, 0, scr, r, lane); }
            __syncthreads(); }
        if (bx >= 128) {
            if (threadIdx.x == 0) { unsigned sp = 0; while (__hip_atomic_load(scan_done, __ATOMIC_RELAXED, __HIP_MEMORY_SCOPE_AGENT) < 64u && ++sp < (1u << 22)) __builtin_amdgcn_s_sleep(2);
                __builtin_amdgcn_fence(__ATOMIC_ACQUIRE, "agent"); asm volatile("s_waitcnt vmcnt(0)" ::: "memory"); }
            __syncthreads();
            pg8::Gemm g{AUG, Wbig, 1024, 256, 512, 512, 512, (size_t)1024 * 512, (size_t)256 * 512, 32}; pg8::StaticOrder S; S.init(1024, 256, 32, G - 128, bx - 128);
            pg8::EpiY E{ZB}; pg8::gemm_phase<pg8::EpiY, true>(lds, g, S, E); }
    }
    SEAM(6);
    if (IN(7)) { pg8::Gemm g{ZB, Wglu, M, 512, 512, 512, 512, 0, 0, 1}; pg8::StaticOrder S; S.init(M, 512, 1, G, bx);
        pg8::EpiGlu E{ZB, args.in[19], Z2B}; pg8::gemm_phase<pg8::EpiGlu, true>(lds, g, S, E); }
    SEAM(7);
    if (IN(8)) { pg8::StaticOrder S; S.init(M, DM, 1, G, bx);
        { pg8::Gemm g{QB_, Wab, M, DM, 512, 512, 512, 0, 0, 1}; pg8::EpiBranch<false> E{(const unsigned char*)GATES, 0, MG}; pg8::gemm_phase<pg8::EpiBranch<false>, true>(lds, g, S, E); }
        { pg8::Gemm g{Z2B, Wsb, M, DM, 512, 512, 512, 0, 0, 1}; pg8::EpiBranch<true> E{(const unsigned char*)GATES, 1024, MG}; pg8::gemm_phase<pg8::EpiBranch<true>, true>(lds, g, S, E); } }
    SEAM(8);
    if (IN(9)) { pg8::Gemm g{MG, Wout, M, DM, DM, DM, DM, 0, 0, 1}; pg8::StaticOrder S; S.init(M, DM, 1, G, bx);
        pg8::EpiResid<true> E{nullptr, XB, ss2, 1.0f}; pg8::gemm_phase<pg8::EpiResid<true>, true>(lds, g, S, E); }
    SEAM(9);
    if (IN(10)) { pg8::Gemm g{XB, W2gu, M, 2 * FF, DM, DM, DM, 0, 0, 1}; pg8::StaticOrder S; S.init(M, 2 * FF, 1, G, bx);
        pg8::EpiSwiglu E{ss2, ACT}; pg8::gemm_phase<pg8::EpiSwiglu, true>(lds, g, S, E);
        if (bx >= 128) {
            pg8::Gemm g2{PB, Wpp, M, DM, PLE, PLE, PLE, 0, 0, 1}; pg8::StaticOrder S2; S2.init(M, DM, 1, G - 128, bx - 128);
            pg8::EpiPle1 E2{PTMP}; pg8::gemm_phase<pg8::EpiPle1, true>(lds, g2, S2, E2); } }
    SEAM(10);
    if (IN(11)) { pg8::Gemm g{ACT, W2d, M, DM, FF, 64, FF, 0, 0, 1, (size_t)256 * 64 * 2, (size_t)(FF / 64) * 256 * 64 * 2}; pg8::StaticOrder S; S.init(M, DM, 1, G, bx);
        pg8::EpiResid<true> E{nullptr, XB, ss3, 0.5f}; pg8::gemm_phase<pg8::EpiResid<true>, true>(lds, g, S, E); }
    SEAM(11);
    if (IN(12)) { pg8::StaticOrder S; S.init(M, DM, 1, G, bx);
        { pg8::Gemm g{XB, Wpg, M, DM, DM, DM, DM, 0, 0, 1}; pg8::EpiPle2 E{ss3, PTMP, XB, out}; pg8::gemm_phase<pg8::EpiPle2, true>(lds, g, S, E); } }
#undef IN
#undef SEAM
}

#ifndef MK_N_LAUNCHES
#define MK_N_LAUNCHES 1
#endif
extern "C" void kernel_launch(void* const* d_in, const int* in_sizes, int n_in, void* d_out, int out_size, void* d_ws, size_t ws_size, hipStream_t stream) {
    static int grid = 0;
    if (grid == 0) {
        if (n_in != 30 || out_size != M * DM || ws_size < WS_END) { fprintf(stderr, "kernel_launch: unexpected shapes (n_in %d out %d ws %zu)\n", n_in, out_size, ws_size); grid = -1; return; }
        int dev = 0, cus = 0, per_cu = 0;
        hipGetDevice(&dev); hipDeviceGetAttribute(&cus, hipDeviceAttributeMultiprocessorCount, dev);
        if (hipFuncSetAttribute((const void*)mega_fwd, hipFuncAttributeMaxDynamicSharedMemorySize, LDS_BYTES) != hipSuccess) { fprintf(stderr, "kernel_launch: hipFuncSetAttribute failed\n"); grid = -1; return; }
        if (hipOccupancyMaxActiveBlocksPerMultiprocessor(&per_cu, (const void*)mega_fwd, NWAVES * 64, LDS_BYTES) != hipSuccess || per_cu < 1) { fprintf(stderr, "kernel_launch: occupancy query says %d\n", per_cu); per_cu = 1; }
        (void)hipGetLastError();
        grid = cus;
        fprintf(stderr, "kernel_launch: grid %d (cus %d, per_cu %d)\n", grid, cus, per_cu);
    }
    if (grid < 0) return;
    if (hipMemsetAsync((char*)d_ws + WS_CTL, 0, CTL_BYTES, stream) != hipSuccess) { fprintf(stderr, "kernel_launch: memset failed\n"); return; }
    Args a{};
    for (int i = 0; i < 30; ++i) a.in[i] = (const float*)d_in[i];
    a.out = (float*)d_out; a.ws = (unsigned char*)d_ws;
#if MK_N_LAUNCHES == 1
    a.ph_lo = 0; a.ph_hi = N_PHASES;
    void* params[] = {&a};
    hipError_t e = hipLaunchCooperativeKernel((const void*)mega_fwd, dim3(grid), dim3(NWAVES * 64), params, LDS_BYTES, stream);
    if (e != hipSuccess) fprintf(stderr, "kernel_launch: cooperative launch failed: %s\n", hipGetErrorString(e));
#else
    for (int ph = 0; ph < N_PHASES; ++ph) { a.ph_lo = ph; a.ph_hi = ph + 1;
        hipLaunchKernelGGL(mega_fwd, dim3(grid), dim3(NWAVES * 64), LDS_BYTES, stream, a); }
#endif
}
```
